# Optimizing an MI355X kernel written in HIP

```python
import math
import jax, jax.numpy as jnp
from jax import lax
import numpy as np

D_MODEL = 2048
BATCH = 4
SEQ = 2048
DEPTH = 1
DEC_BATCH = 8
DEC_SEQ = 4
PAST_LEN = 16384
PAGE_SIZE = 128

N_HEADS = 8
HEAD_DIM = 128
ATTN_WIDTH = N_HEADS * HEAD_DIM
IDX_HEADS = 16
IDX_DIM = 64
TOPK_MAX = 256
CONV_WIDTH = D_MODEL // 2
CONV_K = 3
D_FF = 4 * D_MODEL
N_BUCKETS = 32
MAX_DISTANCE = 128
Q_BLOCK = 64
EPS = 1e-6
SPLITS = (ATTN_WIDTH, ATTN_WIDTH, ATTN_WIDTH,
          IDX_HEADS * IDX_DIM, IDX_DIM, IDX_HEADS,
          CONV_WIDTH, CONV_WIDTH, CONV_WIDTH,
          D_MODEL, D_MODEL)
N_IN = sum(SPLITS)

kernel_name = "hybrid_dsa_shortconv_gated_step"


def rmsnorm(x, g):
    xf = x.astype(jnp.float32)
    y = xf * lax.rsqrt(jnp.mean(xf * xf, axis=-1, keepdims=True) + EPS)
    return (y * g.astype(jnp.float32)).astype(x.dtype)


def rel_bucket(n):
    n = jnp.maximum(n, 0)
    max_exact = N_BUCKETS // 2
    nf = jnp.maximum(n, max_exact).astype(jnp.float32)
    large = max_exact + (jnp.log(nf / max_exact) / math.log(MAX_DISTANCE / max_exact)
                         * (N_BUCKETS - max_exact)).astype(jnp.int32)
    large = jnp.minimum(large, N_BUCKETS - 1)
    return jnp.where(n < max_exact, n, large)


def split_proj(h, w_in):
    B, T = h.shape[:2]
    p = h @ w_in
    pieces, off = [], 0
    for w in SPLITS:
        pieces.append(p[..., off:off + w])
        off += w
    q, k, v, qi, ki, wi, cx, cb, cc, ga, gb = pieces
    q = q.reshape(B, T, N_HEADS, HEAD_DIM)
    k = k.reshape(B, T, N_HEADS, HEAD_DIM)
    v = v.reshape(B, T, N_HEADS, HEAD_DIM)
    qi = qi.reshape(B, T, IDX_HEADS, IDX_DIM)
    return q, k, v, qi, ki, wi, cx, cb, cc, ga, gb


def indexer_topk(qi, wi, ki, q_pos, topk):
    s = jnp.einsum('bthd,bsd->bths', qi.astype(jnp.float32), ki.astype(jnp.float32)) * (IDX_DIM ** -0.5)
    score = jnp.einsum('bths,bth->bts', jax.nn.relu(s), wi.astype(jnp.float32) * (IDX_HEADS ** -0.5))
    key_pos = jnp.arange(ki.shape[1])
    adm = key_pos[None, None, :] <= q_pos[None, :, None]
    score = jnp.where(adm, score, -jnp.inf)
    _, idx = lax.top_k(score, topk)
    valid = idx <= q_pos[None, :, None]
    return idx, valid


def sparse_attend(q, k_sel, v_sel, idx, valid, q_pos, rel_bias):
    logits = jnp.einsum('bthd,btkhd->bthk', q.astype(jnp.float32), k_sel.astype(jnp.float32)) * (HEAD_DIM ** -0.5)
    bias = rel_bias.astype(jnp.float32)[rel_bucket(q_pos[None, :, None] - idx)]
    logits = logits + jnp.moveaxis(bias, -1, 2)
    logits = jnp.where(valid[:, :, None, :], logits, -jnp.inf)
    p = jax.nn.softmax(logits, axis=-1)
    out = jnp.einsum('bthk,btkhd->bthd', p, v_sel.astype(jnp.float32))
    return out.astype(q.dtype)


def prompt_attention(q, k, v, qi, ki, wi, rel_bias):
    B, T = q.shape[:2]
    topk = min(TOPK_MAX, T // 4)
    nb = T // Q_BLOCK
    bidx = jnp.arange(B)[:, None, None]

    def block(args):
        qb, qib, wib, pos = args
        idx, valid = indexer_topk(qib, wib, ki, pos, topk)
        ks = k[bidx, idx]
        vs = v[bidx, idx]
        return sparse_attend(qb, ks, vs, idx, valid, pos, rel_bias)

    def to_blocks(a):
        return jnp.moveaxis(a.reshape((B, nb, Q_BLOCK) + a.shape[2:]), 1, 0)

    pos = jnp.arange(T).reshape(nb, Q_BLOCK)
    out = lax.map(block, (to_blocks(q), to_blocks(qi), to_blocks(wi), pos))
    return jnp.moveaxis(out, 0, 1).reshape(B, T, N_HEADS, HEAD_DIM)


def sample_attention(q, k_new, v_new, qi, ki_new, wi, cache_k, cache_v, cache_kidx, page_table, rel_bias):
    DB, T = q.shape[:2]
    n_pages = page_table.shape[1]
    ps = cache_k.shape[1]
    past = n_pages * ps
    topk = min(TOPK_MAX, (past + T) // 4)
    ki_past = cache_kidx[page_table].reshape(DB, past, IDX_DIM)
    ki_all = jnp.concatenate([ki_past.astype(ki_new.dtype), ki_new], axis=1)
    q_pos = past + jnp.arange(T)
    idx, valid = indexer_topk(qi, wi, ki_all, q_pos, topk)
    bidx = jnp.arange(DB)[:, None, None]
    in_past = (idx < past)[..., None, None]
    pidx = jnp.minimum(idx, past - 1)
    phys = page_table[bidx, pidx // ps]
    off = pidx % ps
    nidx = jnp.clip(idx - past, 0, T - 1)
    ks = jnp.where(in_past, cache_k[phys, off].astype(k_new.dtype), k_new[bidx, nidx])
    vs = jnp.where(in_past, cache_v[phys, off].astype(v_new.dtype), v_new[bidx, nidx])
    return sparse_attend(q, ks, vs, idx, valid, q_pos, rel_bias)


def causal_conv(u, prev, conv_w):
    T = u.shape[1]
    full = jnp.concatenate([prev.astype(u.dtype), u], axis=1)
    y = sum(conv_w[j] * full[:, j:j + T] for j in range(CONV_K))
    return y, full[:, -(CONV_K - 1):]


def mix_out(attn, conv_y, cb, ga, gb, w_pa, w_pb, w_o):
    B, T = attn.shape[:2]
    a = attn.reshape(B, T, ATTN_WIDTH) @ w_pa
    c = (cb * conv_y) @ w_pb
    m = jax.nn.sigmoid(ga) * a + jax.nn.sigmoid(gb) * c
    return m @ w_o


def mlp(h, w1, w2):
    return jnp.square(jax.nn.relu(h @ w1)) @ w2


def setup_inputs(seed: int = 0) -> dict:
    key = jax.random.key(seed)
    ks = jax.random.split(key, 20)
    n_pages = PAST_LEN // PAGE_SIZE
    n_pool = (DEC_BATCH * n_pages * 5) // 4
    nrm = lambda k, shape, scale: jax.random.normal(k, shape, jnp.float32) * scale
    page_table = jax.random.permutation(ks[0], n_pool)[:DEC_BATCH * n_pages].reshape(DEC_BATCH, n_pages).astype(jnp.int32)
    return {
        "x_prompt": nrm(ks[1], (BATCH, SEQ, D_MODEL), 1.0),
        "x_sample": nrm(ks[2], (DEC_BATCH, DEC_SEQ, D_MODEL), 1.0),
        "cache_k": nrm(ks[3], (DEPTH, n_pool, PAGE_SIZE, N_HEADS, HEAD_DIM), 1.0),
        "cache_v": nrm(ks[4], (DEPTH, n_pool, PAGE_SIZE, N_HEADS, HEAD_DIM), 1.0),
        "cache_kidx": nrm(ks[5], (DEPTH, n_pool, PAGE_SIZE, IDX_DIM), 1.0),
        "state_conv": nrm(ks[6], (DEPTH, DEC_BATCH, CONV_K - 1, CONV_WIDTH), 1.0),
        "page_table": page_table,
        "rel_bias": nrm(ks[7], (N_BUCKETS, N_HEADS), 0.1),
        "norm_mix_g": 1.0 + nrm(ks[8], (DEPTH, D_MODEL), 0.01),
        "w_in": nrm(ks[9], (DEPTH, D_MODEL, N_IN), D_MODEL ** -0.5),
        "conv_w": nrm(ks[10], (DEPTH, CONV_K, CONV_WIDTH), CONV_K ** -0.5),
        "w_pa": nrm(ks[11], (DEPTH, ATTN_WIDTH, D_MODEL), ATTN_WIDTH ** -0.5),
        "w_pb": nrm(ks[12], (DEPTH, CONV_WIDTH, D_MODEL), CONV_WIDTH ** -0.5),
        "w_o": nrm(ks[13], (DEPTH, D_MODEL, D_MODEL), D_MODEL ** -0.5),
        "norm_mlp_g": 1.0 + nrm(ks[14], (DEPTH, D_MODEL), 0.01),
        "w_mlp_in": nrm(ks[15], (DEPTH, D_MODEL, D_FF), D_MODEL ** -0.5),
        "w_mlp_out": nrm(ks[16], (DEPTH, D_FF, D_MODEL), D_FF ** -0.5),
        "norm_final_g": 1.0 + nrm(ks[17], (D_MODEL,), 0.01),
    }


def reference(x_prompt, x_sample, cache_k, cache_v, cache_kidx, state_conv, page_table, rel_bias,
              norm_mix_g, w_in, conv_w, w_pa, w_pb, w_o, norm_mlp_g, w_mlp_in, w_mlp_out, norm_final_g):
    xp, xs = x_prompt, x_sample
    kp_l, vp_l, kip_l, sp_l, ks_l, vs_l, kis_l, ss_l = [], [], [], [], [], [], [], []
    for l in range(DEPTH):
        hp = rmsnorm(xp, norm_mix_g[l])
        qp, kp, vp, qip, kip, wip, cxp, cbp, ccp, gap, gbp = split_proj(hp, w_in[l])
        ap = prompt_attention(qp, kp, vp, qip, kip, wip, rel_bias)
        up = ccp * cxp
        zero_prev = jnp.zeros((up.shape[0], CONV_K - 1, CONV_WIDTH), up.dtype)
        yconv_p, sp = causal_conv(up, zero_prev, conv_w[l])
        xp = xp + mix_out(ap, yconv_p, cbp, gap, gbp, w_pa[l], w_pb[l], w_o[l])
        xp = xp + mlp(rmsnorm(xp, norm_mlp_g[l]), w_mlp_in[l], w_mlp_out[l])
        hs = rmsnorm(xs, norm_mix_g[l])
        qs, kn, vn, qis, kin, wis, cxs, cbs, ccs, gas, gbs = split_proj(hs, w_in[l])
        a_s = sample_attention(qs, kn, vn, qis, kin, wis, cache_k[l], cache_v[l], cache_kidx[l], page_table, rel_bias)
        us = ccs * cxs
        yconv_s, ss = causal_conv(us, state_conv[l], conv_w[l])
        xs = xs + mix_out(a_s, yconv_s, cbs, gas, gbs, w_pa[l], w_pb[l], w_o[l])
        xs = xs + mlp(rmsnorm(xs, norm_mlp_g[l]), w_mlp_in[l], w_mlp_out[l])
        kp_l.append(kp); vp_l.append(vp); kip_l.append(kip); sp_l.append(sp)
        ks_l.append(kn); vs_l.append(vn); kis_l.append(kin); ss_l.append(ss)
    y_prompt = rmsnorm(xp, norm_final_g)
    y_sample = rmsnorm(xs, norm_final_g)
    k_prompt = jnp.stack(kp_l)
    v_prompt = jnp.stack(vp_l)
    kidx_prompt = jnp.stack(kip_l)
    conv_prompt = jnp.stack(sp_l)
    k_sample = jnp.stack(ks_l)
    v_sample = jnp.stack(vs_l)
    kidx_sample = jnp.stack(kis_l)
    conv_sample = jnp.stack(ss_l)
    return (y_prompt, y_sample, k_prompt, v_prompt, kidx_prompt, conv_prompt,
            k_sample, v_sample, kidx_sample, conv_sample)
```

```cpp
#include <hip/hip_runtime.h>
#include <cstdio>
#include <cstdint>

#ifndef MK_N_LAUNCHES
#define MK_N_LAUNCHES 10
#endif

constexpr int T = 2048, NB = 4, MPR = NB * T;
constexpr int DB = 8, DT = 4, MS = DB * DT;
constexpr int MTOT = MPR + MS;
constexpr int MPAD = 8448;
constexpr int D = 2048, AW = 1024, CWD = 1024, FF = 8192, NH = 8, HD = 128, IH = 16, IDM = 64;
constexpr int NIN = 11344, NINP = 11520;
constexpr int PAST = 16384, PAGE = 128, NPAGES = 128, TOPK = 256;
constexpr float EPS = 1e-6f;
constexpr int SSTR = 16448;
constexpr int NKS = PAST + DT;
constexpr size_t OUT_Y = 0, OUT_YS = 16777216, OUT_K = 16842752, OUT_V = 25231360, OUT_KI = 33619968, OUT_CONV = 34144256,
                 OUT_KS = 34152448, OUT_VS = 34185216, OUT_KIS = 34217984, OUT_CONVS = 34220032;

#define GAS __attribute__((address_space(1)))
#define LAS __attribute__((address_space(3)))
typedef unsigned short bf16;
typedef unsigned v4u __attribute__((ext_vector_type(4)));
typedef unsigned v2u __attribute__((ext_vector_type(2)));
typedef float f32x4 __attribute__((ext_vector_type(4)));
typedef float f32x2 __attribute__((ext_vector_type(2)));
typedef float f32x16 __attribute__((ext_vector_type(16)));
typedef short bf16x8 __attribute__((ext_vector_type(8)));
typedef short s16x4 __attribute__((ext_vector_type(4)));
typedef GAS unsigned gu32;
typedef GAS unsigned long long gu64;
typedef unsigned long long u64;
#define RLX_AGENT __ATOMIC_RELAXED, __HIP_MEMORY_SCOPE_AGENT
#define LDS_WAIT() asm volatile("s_waitcnt lgkmcnt(0)" ::: "memory")
#define VM_WAIT() asm volatile("s_waitcnt vmcnt(0)" ::: "memory")

typedef __bf16 bf16x2_t __attribute__((ext_vector_type(2)));
__device__ __forceinline__ unsigned cvt_pk_bf16(float lo, float hi) { const f32x2 v = {lo, hi}; const bf16x2_t b = __builtin_convertvector(v, bf16x2_t); return __builtin_bit_cast(unsigned, b); }
__device__ __forceinline__ v4u pack8(f32x4 a, f32x4 b) { v4u w; w.x = cvt_pk_bf16(a[0], a[1]); w.y = cvt_pk_bf16(a[2], a[3]); w.z = cvt_pk_bf16(b[0], b[1]); w.w = cvt_pk_bf16(b[2], b[3]); return w; }
__device__ __forceinline__ float bf_lo(unsigned w) { return __uint_as_float(w << 16); }
__device__ __forceinline__ float bf_hi(unsigned w) { return __uint_as_float(w & 0xffff0000u); }
__device__ __forceinline__ float sigmoidf_(float v) { return __builtin_amdgcn_rcpf(1.0f + __builtin_amdgcn_exp2f(-1.4426950408889634f * v)); }

namespace pg8 {
#define PG8_LAS __attribute__((address_space(3)))
typedef unsigned short bf16_t;
typedef short bf16x8 __attribute__((ext_vector_type(8)));
typedef float f32x4 __attribute__((ext_vector_type(4)));
typedef unsigned u32x4 __attribute__((ext_vector_type(4)));
constexpr int BM = 256, BK = 64, HALF = 128, HTB = HALF * BK * 2  , STAGE_BYTES = 8 * HTB, NXCD = 8, WGM = 8;

__host__ __device__ __forceinline__ int lds_byte(int r, int c) { const int st = (r >> 4) * 2 + (c >> 5), rr = r & 15, cc = c & 31, ob = rr * 64 + cc * 2; return st * 1024 + (ob ^ (((ob >> 9) & 1) << 5)); }
__host__ __device__ __forceinline__ void stage_rc(int b, int& R, int& C) { const int st = b / 1024, sb = b % 1024, swz = sb ^ (((sb >> 9) & 1) << 5); R = (st >> 1) * 16 + swz / 64; C = (st & 1) * 32 + (swz % 64) / 2; }
__host__ __device__ __forceinline__ int perm32(int rho) { const int n = rho >> 4, i = rho & 15; return 8 * (i >> 2) + 4 * n + (i & 3); }

struct Unit { int pm, pn, seg; };
struct Gemm { const bf16_t* A0; const bf16_t* B0; const bf16_t* A1; const bf16_t* B1; int K; };

struct StaticOrder {
    int nM, nN, nwg, G, c, nseg;
    __host__ __device__ void init(int M, int N, int G_, int c_, int nseg_ = 1) { nM = M / BM; nN = N / BM; nwg = nM * nN; G = G_; c = c_; nseg = nseg_; }
    __host__ __device__ bool next(int i, Unit& u) const {
        const int ii = i / nseg; u.seg = i - ii * nseg;
        const long L = (long)ii * G + c; if (L >= nwg) return false;
        int wgid = (int)L; { const int q = nwg / NXCD, r = nwg % NXCD, xcd = wgid % NXCD, off = wgid / NXCD; wgid = (xcd < r ? xcd * (q + 1) : r * (q + 1) + (xcd - r) * q) + off; }
        const int nig = WGM * nN, gid = wgid / nig, fm = gid * WGM, gsz = (nM - fm) < WGM ? (nM - fm) : WGM;
        u.pm = fm + ((wgid % nig) % gsz); u.pn = (wgid % nig) / gsz; return true;
    }
    __device__ __forceinline__ void a_ready(const Unit&) const {}
    __device__ __forceinline__ void done(const Unit&) const {}
};
template <class Epi, class Sched, bool ALIGN_EPI = false, bool SP2 = false>
__device__ __forceinline__ void gemm_phase(PG8_LAS unsigned char* lds, const Gemm g, const Sched& S, const Epi& E) {
    const int tid = threadIdx.x, wid = __builtin_amdgcn_readfirstlane(tid >> 6), lane = tid & 63, wr = wid >> 2, wc = wid & 3, fr = lane & 15, fq = lane >> 4;
    const int K = g.K, nt = K / BK;
    unsigned voffA[2], voffB[2];
#pragma unroll
    for (int i = 0; i < 2; ++i) { int R, C; stage_rc(tid * 16 + i * 8192, R, C); const int Rb = Epi::PERM ? ((R & ~31) + perm32(R & 31)) : R;
        voffA[i] = (unsigned)(R * K + C) * 2u; voffB[i] = (unsigned)(Rb * K + C) * 2u; }
    const size_t kstep = (size_t)(BK * 2);
    const size_t hstep = (size_t)HALF * K * 2;
    const size_t tstep = 2 * hstep;
    const unsigned ldsw = (unsigned)wid * 1024u;
    const int aoff = lds_byte(wr * 64 + fr, fq * 8), boff = lds_byte(wc * 32 + fr, fq * 8);
#define PG8_SA(b, h) (((b) * 2 + (h)) * HTB)
#define PG8_SB(b, h) ((4 + (b) * 2 + (h)) * HTB)
#define PG8_STAGE(bufoff, gbase, voff) do { _Pragma("unroll") for (int _i = 0; _i < 2; ++_i) \
        __builtin_amdgcn_global_load_lds((const unsigned*)((const char*)(gbase) + (voff)[_i]), (PG8_LAS unsigned*)(lds + (bufoff) + ldsw + _i * 8192), 16, 0, 0); } while (0)
#define PG8_LDA(dst, b, h) do { _Pragma("unroll") for (int m = 0; m < 4; ++m) _Pragma("unroll") for (int k = 0; k < 2; ++k) dst[m][k] = *(const PG8_LAS bf16x8*)(lds + PG8_SA(b, h) + aoff + m * 2048 + k * 1024); } while (0)
#define PG8_LDB(dst, b, h) do { _Pragma("unroll") for (int n = 0; n < 2; ++n) _Pragma("unroll") for (int k = 0; k < 2; ++k) dst[n][k] = *(const PG8_LAS bf16x8*)(lds + PG8_SB(b, h) + boff + n * 2048 + k * 1024); } while (0)
#define PG8_MMA(ai, bj, At, Bt) do { __builtin_amdgcn_s_setprio(1); _Pragma("unroll") for (int m = 0; m < 4; ++m) _Pragma("unroll") for (int n = 0; n < 2; ++n) _Pragma("unroll") for (int k = 0; k < 2; ++k) \
        acc[ai][bj][m][n] = __builtin_amdgcn_mfma_f32_16x16x32_bf16(Bt[n][k], At[m][k], acc[ai][bj][m][n], 0, 0, 0); __builtin_amdgcn_s_setprio(0); } while (0)
#define PG8_WAIT_V(n) asm volatile("s_waitcnt vmcnt(" #n ")" ::: "memory")
#define PG8_WAIT_L(n) asm volatile("s_waitcnt lgkmcnt(" #n ")" ::: "memory")
#define PG8_BAR __builtin_amdgcn_s_barrier()
#define PG8_SCHED __builtin_amdgcn_sched_barrier(0)
    Unit cur, nxt; int ui = 0;
    if (!S.next(0, cur)) return;
    f32x4 acc[2][2][4][2];
#pragma unroll
    for (int a = 0; a < 2; ++a)
#pragma unroll
        for (int b = 0; b < 2; ++b)
#pragma unroll
            for (int m = 0; m < 4; ++m)
#pragma unroll
                for (int n = 0; n < 2; ++n) acc[a][b][m][n] = (f32x4){0.f, 0.f, 0.f, 0.f};
    bf16x8 At[4][2], B0[2][2], B1[2][2];
    const char* cA = (const char*)(cur.seg ? g.A1 : g.A0) + (size_t)cur.pm * tstep; const char* cB = (const char*)(cur.seg ? g.B1 : g.B0) + (size_t)cur.pn * tstep;
    S.a_ready(cur);
    if constexpr (SP2) {
        PG8_STAGE(PG8_SB(0, 0), cB, voffB); PG8_STAGE(PG8_SB(0, 1), cB + hstep, voffB); PG8_STAGE(PG8_SA(0, 0), cA, voffA); PG8_STAGE(PG8_SA(0, 1), cA + hstep, voffA);
        if (wr == 1) PG8_BAR;
        PG8_WAIT_V(2); PG8_BAR;
        PG8_STAGE(PG8_SB(1, 0), cB + kstep, voffB); PG8_STAGE(PG8_SA(1, 0), cA + kstep, voffA); PG8_STAGE(PG8_SB(1, 1), cB + hstep + kstep, voffB);
        PG8_WAIT_V(6); PG8_BAR;
    } else {
        PG8_STAGE(PG8_SB(0, 0), cB, voffB); PG8_STAGE(PG8_SA(0, 0), cA, voffA); PG8_STAGE(PG8_SB(0, 1), cB + hstep, voffB); PG8_STAGE(PG8_SA(0, 1), cA + hstep, voffA);
        if (wr == 1) PG8_BAR;
        PG8_WAIT_V(4); PG8_BAR;
        PG8_STAGE(PG8_SB(1, 0), cB + kstep, voffB); PG8_STAGE(PG8_SA(1, 0), cA + kstep, voffA); PG8_STAGE(PG8_SB(1, 1), cB + hstep + kstep, voffB);
        PG8_WAIT_V(6); PG8_BAR;
    }
    for (;;) {
        const bool has_next = S.next(ui + 1, nxt);
        const char* nA = has_next ? (const char*)(nxt.seg ? g.A1 : g.A0) + (size_t)nxt.pm * tstep : cA; const char* nB = has_next ? (const char*)(nxt.seg ? g.B1 : g.B0) + (size_t)nxt.pn * tstep : cB;
        for (int t = 0; t < nt; t += 2) {
            const bool last = (t == nt - 2);
            const char* a1 = cA + (size_t)(t + 1) * kstep;
            const char* a2 = last ? nA : cA + (size_t)(t + 2) * kstep; const char* b2 = last ? nB : cB + (size_t)(t + 2) * kstep;
            const char* a3 = a2 + kstep; const char* b3 = b2 + kstep;
            if (last && has_next) S.a_ready(nxt);
            if constexpr (SP2) {
            PG8_LDB(B0, 0, 0); PG8_LDB(B1, 0, 1); PG8_SCHED; PG8_LDA(At, 0, 0); PG8_STAGE(PG8_SA(1, 1), a1 + hstep, voffA);
            PG8_WAIT_V(8); PG8_WAIT_L(0); PG8_BAR; PG8_MMA(0, 0, At, B0); PG8_MMA(0, 1, At, B1); PG8_BAR; PG8_SCHED;
            PG8_LDA(At, 0, 1); PG8_STAGE(PG8_SB(0, 0), b2, voffB); PG8_STAGE(PG8_SB(0, 1), b2 + hstep, voffB); PG8_STAGE(PG8_SA(0, 0), a2, voffA);
            PG8_WAIT_V(8); PG8_WAIT_L(0); PG8_BAR; PG8_MMA(1, 0, At, B0); PG8_MMA(1, 1, At, B1); PG8_BAR; PG8_SCHED;
            PG8_LDB(B0, 1, 0); PG8_LDB(B1, 1, 1); PG8_SCHED; PG8_LDA(At, 1, 0); PG8_STAGE(PG8_SA(0, 1), a2 + hstep, voffA);
            PG8_WAIT_V(8); PG8_WAIT_L(0); PG8_BAR; PG8_MMA(0, 0, At, B0); PG8_MMA(0, 1, At, B1); PG8_BAR; PG8_SCHED;
            PG8_LDA(At, 1, 1); PG8_STAGE(PG8_SB(1, 0), b3, voffB); PG8_STAGE(PG8_SB(1, 1), b3 + hstep, voffB); PG8_STAGE(PG8_SA(1, 0), a3, voffA);
            PG8_WAIT_V(8); PG8_WAIT_L(0); PG8_BAR; PG8_MMA(1, 0, At, B0); PG8_MMA(1, 1, At, B1); PG8_BAR; PG8_SCHED;
            } else {
            PG8_LDB(B0, 0, 0); PG8_SCHED; PG8_LDA(At, 0, 0); PG8_STAGE(PG8_SA(1, 1), a1 + hstep, voffA);
            PG8_WAIT_L(8); PG8_BAR; PG8_WAIT_L(0); PG8_MMA(0, 0, At, B0); PG8_BAR; PG8_SCHED;
            PG8_LDB(B1, 0, 1); PG8_STAGE(PG8_SB(0, 0), b2, voffB);
            PG8_BAR; PG8_WAIT_L(0); PG8_MMA(0, 1, At, B1); PG8_BAR;
            PG8_LDA(At, 0, 1); PG8_STAGE(PG8_SA(0, 0), a2, voffA);
            PG8_BAR; PG8_WAIT_L(0); PG8_MMA(1, 0, At, B0); PG8_BAR; PG8_SCHED;
            PG8_STAGE(PG8_SB(0, 1), b2 + hstep, voffB);
            PG8_WAIT_V(6); PG8_BAR; PG8_MMA(1, 1, At, B1); PG8_BAR;
            PG8_LDB(B0, 1, 0); PG8_SCHED; PG8_LDA(At, 1, 0); PG8_STAGE(PG8_SA(0, 1), a2 + hstep, voffA);
            PG8_WAIT_L(8); PG8_BAR; PG8_WAIT_L(0); PG8_MMA(0, 0, At, B0); PG8_BAR; PG8_SCHED;
            PG8_LDB(B1, 1, 1); PG8_STAGE(PG8_SB(1, 0), b3, voffB);
            PG8_BAR; PG8_WAIT_L(0); PG8_MMA(0, 1, At, B1); PG8_BAR;
            PG8_LDA(At, 1, 1); PG8_STAGE(PG8_SA(1, 0), a3, voffA);
            PG8_BAR; PG8_WAIT_L(0); PG8_MMA(1, 0, At, B0); PG8_BAR; PG8_SCHED;
            PG8_STAGE(PG8_SB(1, 1), b3 + hstep, voffB);
            PG8_WAIT_V(6); PG8_BAR; PG8_MMA(1, 1, At, B1); PG8_BAR;
            }
        }
        if constexpr (ALIGN_EPI) { if (wr == 0) PG8_BAR; }
        if constexpr (!Epi::AFTER_DRAIN) { E(acc, cur, wr, wc, fr, fq); S.done(cur); }
        if (!has_next) break;
        if (Epi::NSEG == 1 || cur.seg == Epi::NSEG - 1) {
#pragma unroll
        for (int a = 0; a < 2; ++a)
#pragma unroll
            for (int b = 0; b < 2; ++b)
#pragma unroll
                for (int m = 0; m < 4; ++m)
#pragma unroll
                    for (int n = 0; n < 2; ++n) acc[a][b][m][n] = (f32x4){0.f, 0.f, 0.f, 0.f};
        }
        cur = nxt; cA = nA; cB = nB; ++ui;
        if constexpr (ALIGN_EPI) { if (wr == 1) PG8_BAR; }
    }
    PG8_WAIT_V(0);
    if constexpr (!ALIGN_EPI) { if (wr == 0) PG8_BAR; }
    PG8_BAR;
    if constexpr (Epi::AFTER_DRAIN) { E.fused(acc, cur, wr, wc, fr, fq, lds, wid, lane); S.done(cur); }
#undef PG8_SA
#undef PG8_SB
#undef PG8_STAGE
#undef PG8_LDA
#undef PG8_LDB
#undef PG8_MMA
#undef PG8_WAIT_V
#undef PG8_WAIT_L
#undef PG8_BAR
#undef PG8_SCHED
}
}
#define PG8_SP2 true
#define PG8_ALIGN true

using pg8::Unit;
#define EPI_ROWS(...) _Pragma("unroll") for (int ai = 0; ai < 2; ++ai) _Pragma("unroll") for (int m = 0; m < 4; ++m) { const int rl = 128 * ai + 64 * wr + 16 * m + fr; const int row = u.pm * 256 + rl; (void)row; \
    _Pragma("unroll") for (int bj = 0; bj < 2; ++bj) { const int c8 = 128 * bj + 32 * wc + 8 * fq; f32x4 v0 = acc[ai][bj][m][0], v1 = acc[ai][bj][m][1]; (void)c8; __VA_ARGS__ } }

struct EpiInProj {
    static constexpr bool PERM = true, AFTER_DRAIN = false; static constexpr int NSEG = 1;
    float* out; bf16 *QH, *KH, *VH, *QI, *KIB, *CXB, *SGA, *SGB; float *WI, *QS;
    __device__ __forceinline__ void operator()(f32x4 (&acc)[2][2][4][2], const Unit& u, int wr, int wc, int fr, int fq) const {
        const int pn = u.pn; const bool samp = (u.pm == 32);
        if (pn < 12) {
            const int which = pn >> 2, cb0 = (pn & 3) * 256;
            bf16* HB = QH + (size_t)which * ((size_t)MPR * AW);
            float* op = out + (which == 1 ? OUT_K : OUT_V); float* qs_or_out = out + (which == 1 ? OUT_KS : OUT_VS); if (which == 0) qs_or_out = QS;
            EPI_ROWS({
                const int col = cb0 + c8;
                if (!samp) {
                    const int b = row >> 11, t = row & 2047, h = col >> 7, d = col & 127;
                    *(v4u*)(HB + ((size_t)((b * NH + h) * T + t)) * HD + d) = pack8(v0, v1);
                    if (which) { float* o = op + (size_t)row * AW + col; *(f32x4*)o = v0; *(f32x4*)(o + 4) = v1; }
                } else if (rl < MS) {
                    float* o = qs_or_out + (size_t)rl * AW + col; *(f32x4*)o = v0; *(f32x4*)(o + 4) = v1;
                }
            })
        } else if (pn < 16) {
            const int cb0 = (pn - 12) * 256;
            EPI_ROWS({ if (!samp || rl < MS) *(v4u*)(QI + (size_t)row * 1024 + cb0 + c8) = pack8(v0, v1); })
        } else if (pn == 16) {
            EPI_ROWS({
                if (bj == 0 && (!samp || rl < MS)) {
                    if (wc < 2) { float* o = samp ? out + OUT_KIS + (size_t)rl * IDM + c8 : out + OUT_KI + (size_t)row * IDM + c8; *(f32x4*)o = v0; *(f32x4*)(o + 4) = v1;
                                  *(v4u*)(KIB + (size_t)row * IDM + c8) = pack8(v0, v1); }
                    else if (wc == 2 && fq < 2) { float* o = WI + (size_t)row * IH + 8 * fq; *(f32x4*)o = v0 * 0.03125f; *(f32x4*)(o + 4) = v1 * 0.03125f; }
                }
            })
        } else if (pn < 29) {
            const int sg = (pn - 17) >> 2, cb0 = ((pn - 17) & 3) * 256;
            bf16* P = CXB + (size_t)sg * MPAD * CWD;
            EPI_ROWS({ if (!samp || rl < MS) *(v4u*)(P + (size_t)row * CWD + cb0 + c8) = pack8(v0, v1); })
        } else {
            const bool isb = pn >= 37; const int cb0 = (pn - (isb ? 37 : 29)) * 256; bf16* P = isb ? SGB : SGA;
            EPI_ROWS({ if (!samp || rl < MS) {
                const f32x4 s0 = {sigmoidf_(v0[0]), sigmoidf_(v0[1]), sigmoidf_(v0[2]), sigmoidf_(v0[3])}, s1 = {sigmoidf_(v1[0]), sigmoidf_(v1[1]), sigmoidf_(v1[2]), sigmoidf_(v1[3])};
                *(v4u*)(P + (size_t)row * D + cb0 + c8) = pack8(s0, s1); } })
        }
    }
};

struct EpiMix {
    static constexpr bool PERM = true, AFTER_DRAIN = false; static constexpr int NSEG = 2;
    const bf16 *SGA, *SGB; bf16* MX;
    __device__ __forceinline__ void operator()(f32x4 (&acc)[2][2][4][2], const Unit& u, int wr, int wc, int fr, int fq) const {
        const int cb0 = u.pn * 256;
        if (u.seg == 0) {
            EPI_ROWS({
                const v4u a = *(const v4u*)(SGA + (size_t)row * D + cb0 + c8), b = *(const v4u*)(SGB + (size_t)row * D + cb0 + c8);
                f32x4 r0, r1;
                r0[0] = bf_lo(a.x) * __builtin_amdgcn_rcpf(bf_lo(b.x)); r0[1] = bf_hi(a.x) * __builtin_amdgcn_rcpf(bf_hi(b.x)); r0[2] = bf_lo(a.y) * __builtin_amdgcn_rcpf(bf_lo(b.y)); r0[3] = bf_hi(a.y) * __builtin_amdgcn_rcpf(bf_hi(b.y));
                r1[0] = bf_lo(a.z) * __builtin_amdgcn_rcpf(bf_lo(b.z)); r1[1] = bf_hi(a.z) * __builtin_amdgcn_rcpf(bf_hi(b.z)); r1[2] = bf_lo(a.w) * __builtin_amdgcn_rcpf(bf_lo(b.w)); r1[3] = bf_hi(a.w) * __builtin_amdgcn_rcpf(bf_hi(b.w));
                acc[ai][bj][m][0] = v0 * r0; acc[ai][bj][m][1] = v1 * r1;
            })
        } else {
            EPI_ROWS({
                const v4u b = *(const v4u*)(SGB + (size_t)row * D + cb0 + c8);
                const f32x4 g0 = {bf_lo(b.x), bf_hi(b.x), bf_lo(b.y), bf_hi(b.y)}, g1 = {bf_lo(b.z), bf_hi(b.z), bf_lo(b.w), bf_hi(b.w)};
                *(v4u*)(MX + (size_t)row * D + cb0 + c8) = pack8(v0 * g0, v1 * g1);
            })
        }
    }
};

__device__ __forceinline__ void ssq_add(float* ssq, int row, float s, int fq) {
    s += __shfl_xor(s, 16); s += __shfl_xor(s, 32);
    if (fq == 0) atomicAdd(ssq + row, s);
}

struct EpiWo {
    static constexpr bool PERM = true, AFTER_DRAIN = false; static constexpr int NSEG = 1;
    const float *xp, *xs; float* X2; bf16* XB; float* SSQ;
    __device__ __forceinline__ void operator()(f32x4 (&acc)[2][2][4][2], const Unit& u, int wr, int wc, int fr, int fq) const {
        const int cb0 = u.pn * 256; const bool samp = (u.pm == 32);
#pragma unroll
        for (int ai = 0; ai < 2; ++ai)
#pragma unroll
            for (int m = 0; m < 4; ++m) { const int rl = 128 * ai + 64 * wr + 16 * m + fr; const int row = u.pm * 256 + rl; float s = 0.f;
                const bool valid = !samp || rl < MS; const float* xr = samp ? xs + (size_t)(rl & (MS - 1)) * D : xp + (size_t)row * D;
#pragma unroll
                for (int bj = 0; bj < 2; ++bj) { const int c = cb0 + 128 * bj + 32 * wc + 8 * fq;
                    f32x4 a0 = *(const f32x4*)(xr + c), a1 = *(const f32x4*)(xr + c + 4);
                    if (!valid) { a0 = (f32x4){0.f, 0.f, 0.f, 0.f}; a1 = a0; }
                    const f32x4 v0 = acc[ai][bj][m][0] + a0, v1 = acc[ai][bj][m][1] + a1;
                    *(f32x4*)(X2 + (size_t)row * D + c) = v0; *(f32x4*)(X2 + (size_t)row * D + c + 4) = v1;
                    *(v4u*)(XB + (size_t)row * D + c) = pack8(v0, v1);
                    s += (v0[0] * v0[0] + v0[1] * v0[1]) + (v0[2] * v0[2] + v0[3] * v0[3]) + (v1[0] * v1[0] + v1[1] * v1[1]) + (v1[2] * v1[2] + v1[3] * v1[3]); }
                ssq_add(SSQ, row, s, fq); }
    }
};

struct EpiUp {
    static constexpr bool PERM = true, AFTER_DRAIN = false; static constexpr int NSEG = 1;
    const float* SSQ; bf16* HID;
    __device__ __forceinline__ void operator()(f32x4 (&acc)[2][2][4][2], const Unit& u, int wr, int wc, int fr, int fq) const {
        const int cb0 = u.pn * 256;
#pragma unroll
        for (int ai = 0; ai < 2; ++ai)
#pragma unroll
            for (int m = 0; m < 4; ++m) { const int rl = 128 * ai + 64 * wr + 16 * m + fr; const int row = u.pm * 256 + rl;
                const float rs = __builtin_amdgcn_rsqf(__hip_atomic_load(SSQ + row, RLX_AGENT) * (1.0f / D) + EPS);
#pragma unroll
                for (int bj = 0; bj < 2; ++bj) { const int c = cb0 + 128 * bj + 32 * wc + 8 * fq;
                    f32x4 v0 = acc[ai][bj][m][0] * rs, v1 = acc[ai][bj][m][1] * rs;
#pragma unroll
                    for (int j = 0; j < 4; ++j) { const float a = fmaxf(v0[j], 0.f), b = fmaxf(v1[j], 0.f); v0[j] = a * a; v1[j] = b * b; }
                    *(v4u*)(HID + (size_t)row * FF + c) = pack8(v0, v1); } }
    }
};

struct EpiDown {
    static constexpr bool PERM = true, AFTER_DRAIN = false; static constexpr int NSEG = 1;
    const float* X2; float* out; float* SSQ;
    __device__ __forceinline__ void operator()(f32x4 (&acc)[2][2][4][2], const Unit& u, int wr, int wc, int fr, int fq) const {
        const int cb0 = u.pn * 256; const bool samp = (u.pm == 32);
#pragma unroll
        for (int ai = 0; ai < 2; ++ai)
#pragma unroll
            for (int m = 0; m < 4; ++m) { const int rl = 128 * ai + 64 * wr + 16 * m + fr; const int row = u.pm * 256 + rl; float s = 0.f;
                const bool valid = !samp || rl < MS; float* orow = samp ? out + OUT_YS + (size_t)(rl & (MS - 1)) * D : out + OUT_Y + (size_t)row * D;
#pragma unroll
                for (int bj = 0; bj < 2; ++bj) { const int c = cb0 + 128 * bj + 32 * wc + 8 * fq;
                    const f32x4 v0 = acc[ai][bj][m][0] + *(const f32x4*)(X2 + (size_t)row * D + c), v1 = acc[ai][bj][m][1] + *(const f32x4*)(X2 + (size_t)row * D + c + 4);
                    if (valid) { *(f32x4*)(orow + c) = v0; *(f32x4*)(orow + c + 4) = v1; }
                    s += (v0[0] * v0[0] + v0[1] * v0[1]) + (v0[2] * v0[2] + v0[3] * v0[3]) + (v1[0] * v1[0] + v1[1] * v1[1]) + (v1[2] * v1[2] + v1[3] * v1[3]); }
                ssq_add(SSQ, row, s, fq); }
    }
};
#define XB_TMO      128
#define XB_XCNT(j)  (256  + 64 * (j))
#define XB_XSUB(j)  (1280 + 64 * (j))
#define XB_XGEN(j)  (2304 + 64 * (j))
#define XB_TOP      3328
#define XB_TOPGEN   3392
#define XCD_BAR_WORDS 3456
#define XB_SPIN_CAP (1u << 18)

__device__ __forceinline__ unsigned xb_ld(unsigned* p)              { return __hip_atomic_load(p, __ATOMIC_RELAXED, __HIP_MEMORY_SCOPE_AGENT); }
__device__ __forceinline__ unsigned xb_add(unsigned* p, unsigned v) { return __hip_atomic_fetch_add(p, v, __ATOMIC_RELAXED, __HIP_MEMORY_SCOPE_AGENT); }
__device__ __forceinline__ unsigned xb_xcc_id() { return (unsigned)__builtin_amdgcn_s_getreg((3 << 11) | 20) & 0xFu; }
#define XB_SPIN(cond, bar) do { unsigned _sp = 0; while (cond) { __builtin_amdgcn_s_sleep(1); \
    if ((++_sp & 255u) == 0u) { if (xb_ld(&(bar)[XB_TMO])) break; if (_sp > XB_SPIN_CAP) { atomicAdd(&(bar)[XB_TMO], 1u); break; } } } } while (0)

struct XcdBarrier {
    unsigned* bar; unsigned x;
    volatile LAS unsigned* st;
};

__device__ __forceinline__ XcdBarrier xcd_barrier_post(unsigned* bar, volatile LAS unsigned* st) {
    XcdBarrier b; b.bar = bar; b.x = xb_xcc_id(); b.st = st;
    if (threadIdx.x == 0) (void)xb_add(&bar[XB_XCNT(b.x)], 1u);
    return b;
}
__device__ __forceinline__ void xcd_barrier_complete(unsigned* bar, unsigned x, unsigned& nloc, unsigned& nx) {
    const unsigned G = gridDim.x * gridDim.y * gridDim.z;
    unsigned sum, cnt, mine, sp = 0u;
    for (;;) {
        sum = 0u; cnt = 0u; mine = 0u;
#pragma unroll
        for (unsigned j = 0; j < 16; ++j) { const unsigned c = xb_ld(&bar[XB_XCNT(j)]); sum += c; cnt += (c > 0u) ? 1u : 0u; mine = (j == x) ? c : mine; }
        if (sum == G) break;
        __builtin_amdgcn_s_sleep(1);
        if ((++sp & 255u) == 0u) { if (xb_ld(&bar[XB_TMO])) break; if (sp > XB_SPIN_CAP) { atomicAdd(&bar[XB_TMO], 1u); break; } }
    }
    nloc = mine > 0u ? mine : 1u; nx = cnt > 0u ? cnt : 1u;
}

__device__ __forceinline__ void xcd_barrier(const XcdBarrier& b) {
    asm volatile("s_waitcnt vmcnt(0)" ::: "memory");
    __syncthreads();
    if (threadIdx.x == 0) {
        unsigned* bar = b.bar;
        __builtin_amdgcn_s_waitcnt(0);
        unsigned nloc = b.st[0], nx = b.st[1];
        if (nloc == 0u) { xcd_barrier_complete(bar, b.x, nloc, nx); b.st[0] = nloc; b.st[1] = nx; }
        const unsigned old = xb_add(&bar[XB_XSUB(b.x)], 1u);
        const unsigned gen = old / nloc;
        if (old + 1u == (gen + 1u) * nloc) {
            __builtin_amdgcn_fence(__ATOMIC_RELEASE, "agent");
            asm volatile("s_waitcnt vmcnt(0)" ::: "memory");
            const unsigned og = xb_add(&bar[XB_TOP], 1u);
            const unsigned tg = og / nx;
            if (og + 1u == (tg + 1u) * nx) xb_add(&bar[XB_TOPGEN], 1u);
            else XB_SPIN(xb_ld(&bar[XB_TOPGEN]) == tg, bar);
            __builtin_amdgcn_fence(__ATOMIC_ACQUIRE, "agent");
            xb_add(&bar[XB_XGEN(b.x)], 1u);
            asm volatile("s_waitcnt vmcnt(0)" ::: "memory");
        } else {
            XB_SPIN(xb_ld(&bar[XB_XGEN(b.x)]) == gen, bar);
            __builtin_amdgcn_fence(__ATOMIC_ACQUIRE, "agent");
            asm volatile("s_waitcnt vmcnt(0)" ::: "memory");
        }
    }
    __syncthreads();
}
namespace att {
constexpr int D = 128;
constexpr float THR = 8.f;
constexpr bool WSKIP = false;
constexpr int OSTR = 1024;
constexpr int STRIP_OFF = 69632, STRIP_N = 2368;
typedef unsigned short bf16;
constexpr float SCALE = 0.08838834764831845f;
constexpr int NW = 8, QBLK = 32, KVBLK = 64, QB = NW * QBLK;
constexpr int SHM_V = KVBLK * D * 2, SHM_K = KVBLK * D * 2;
constexpr int LDS_BYTES = 2 * SHM_V + 2 * SHM_K + NW * 64 * 4;

typedef short bf16x8 __attribute__((ext_vector_type(8)));
typedef short s16x4 __attribute__((ext_vector_type(4)));
typedef float f32x16 __attribute__((ext_vector_type(16)));
typedef float f32x4 __attribute__((ext_vector_type(4)));
typedef unsigned u32x4 __attribute__((ext_vector_type(4)));
template <class A, class Bt> struct same_t { static constexpr bool v = false; };
template <class A> struct same_t<A, A> { static constexpr bool v = true; };

#define KSWZ(row, colB) ((row) * 256 + ((colB) ^ (((row) & 7) << 4)))
#define SBAR() __builtin_amdgcn_sched_barrier(0)
__device__ __forceinline__ int v_st(int k, int c) { const int kk = (k & ~0xC) | ((k & 4) << 1) | ((k & 8) >> 1); return ((kk >> 3) * 4 + (c >> 5)) * 512 + ((kk & 7) * 32 + (c & 31)) * 2; }
__device__ __forceinline__ int v_rd_base(int lane) { return ((lane & 3) << 3) | (((lane >> 2) & 3) << 6) | (((lane >> 4) & 1) << 5) | (((lane >> 5) & 1) << 8); }
constexpr int v_rd_off(int d0, int ks, int half) { return d0 * 512 + ks * 4096 + half * 2048; }
__device__ __forceinline__ int crow(int r, int hi) { return (r & 3) + 8 * (r >> 2) + 4 * hi; }
__device__ __forceinline__ unsigned cvtpk(float lo, float hi) {
    unsigned r; asm volatile("v_cvt_pk_bf16_f32 %0, %1, %2" : "=v"(r) : "v"(lo), "v"(hi)); return r;
}
__device__ __forceinline__ bf16x8 pack8(f32x4 a, f32x4 b) {
    u32x4 w = {cvtpk(a[0], a[1]), cvtpk(a[2], a[3]), cvtpk(b[0], b[1]), cvtpk(b[2], b[3])};
    return *reinterpret_cast<bf16x8*>(&w);
}
template <class T> __device__ __forceinline__ bf16x8 load8(const T* p) {
    if constexpr (same_t<T, float>::v) { return pack8(*(const f32x4*)p, *(const f32x4*)(p + 4)); }
    else { return *reinterpret_cast<const bf16x8*>(p); }
}
__device__ __forceinline__ void mask_tile(f32x16& p0, f32x16& p1, int dq, unsigned W) {
    const float NEG = -__builtin_inff();
#pragma unroll
    for (int r = 0; r < 16; ++r) {
        const int c = (r & 3) + 8 * (r >> 2);
        if ((unsigned)(dq - c) >= W) p0[r] = NEG;
        if ((unsigned)(dq - c - 32) >= W) p1[r] = NEG;
    }
}
__device__ __forceinline__ void mask_bias_tile(f32x16& p0, f32x16& p1, unsigned long long w, const __attribute__((address_space(3))) float* sp, int hi) {
    const float NEG = -__builtin_inff();
    const unsigned wl = (unsigned)w >> (4 * hi), wh = (unsigned)(w >> 32) >> (4 * hi);
#pragma unroll
    for (int r = 0; r < 16; ++r) { const int c = (r & 3) + 8 * (r >> 2);
        p0[r] = ((wl >> c) & 1u) ? p0[r] + sp[59 - c] : NEG;
        p1[r] = ((wh >> c) & 1u) ? p1[r] + sp[27 - c] : NEG; }
}
__device__ __forceinline__ void partialSM(f32x16& p0, f32x16& p1, float& m_reg, float& mn, float& alpha) {
    float pmax = p0[0]; for (int r = 1; r < 16; ++r) pmax = fmaxf(pmax, p0[r]); for (int r = 0; r < 16; ++r) pmax = fmaxf(pmax, p1[r]);
    { auto rr = __builtin_amdgcn_permlane32_swap(__float_as_uint(pmax), __float_as_uint(pmax), false, false);
      pmax = fmaxf(__uint_as_float(rr[0]), __uint_as_float(rr[1])); }
    constexpr float C2 = 1.4426950408889634f * SCALE;
    if (__builtin_expect(__all((pmax - m_reg) * SCALE <= THR), 1)) { mn = m_reg; alpha = 1.f; }
    else { mn = fmaxf(m_reg, pmax); alpha = __builtin_amdgcn_exp2f((m_reg - mn) * C2); m_reg = mn; }
    const float mnL = -mn * C2;
    for (int r = 0; r < 16; ++r) p0[r] = fmaf(p0[r], C2, mnL); for (int r = 0; r < 16; ++r) p1[r] = fmaf(p1[r], C2, mnL);
    for (int r = 0; r < 16; ++r) p0[r] = __builtin_amdgcn_exp2f(p0[r]);
}
__device__ __forceinline__ void finishSM(f32x16& p0, f32x16& p1, float alpha, float& l_reg, bf16x8& pa0, bf16x8& pa1, bf16x8& pa2, bf16x8& pa3) {
    for (int r = 0; r < 16; ++r) p1[r] = __builtin_amdgcn_exp2f(p1[r]);
    float ps = 0; for (int r = 0; r < 16; ++r) ps += p0[r]; for (int r = 0; r < 16; ++r) ps += p1[r];
    { auto rr = __builtin_amdgcn_permlane32_swap(__float_as_uint(ps), __float_as_uint(ps), false, false);
      ps = __uint_as_float(rr[0]) + __uint_as_float(rr[1]); }
    l_reg = l_reg * alpha + ps;
#define PK4(P, B_, OUT) do { unsigned a0 = cvtpk(P[B_+0], P[B_+1]), a1 = cvtpk(P[B_+2], P[B_+3]);                          \
        unsigned b0 = cvtpk(P[B_+4], P[B_+5]), b1 = cvtpk(P[B_+6], P[B_+7]);                                             \
        auto r0 = __builtin_amdgcn_permlane32_swap(a0, b0, false, false); auto r1 = __builtin_amdgcn_permlane32_swap(a1, b1, false, false); \
        u32x4 w = {r0[0], r1[0], r0[1], r1[1]}; OUT = *reinterpret_cast<bf16x8*>(&w); } while (0)
    PK4(p0, 0, pa0); PK4(p0, 8, pa1); PK4(p1, 0, pa2); PK4(p1, 8, pa3);
#undef PK4
}
template <int KB, bool SK>
__device__ __forceinline__ void qkt(f32x16& p0, f32x16& p1, const char* K_lds, int r32, int hi, const bf16x8* qr, bool act) {
    if (SK && !act) { const float NEG = -__builtin_inff();
#pragma unroll
        for (int r = 0; r < 16; ++r) { p0[r] = NEG; p1[r] = NEG; } return; }
    p0 = f32x16{}; p1 = f32x16{};
    const char* kb[4];
#pragma unroll
    for (int dd = 0; dd < 4; ++dd) kb[dd] = K_lds + KB * SHM_K + KSWZ(r32, (dd * 16 + hi * 8) * 2);
#pragma unroll
    for (int d0 = 0; d0 < 8; ++d0) { const char* a = kb[d0 & 3] + (d0 >> 2) * 128;
        bf16x8 b0 = *reinterpret_cast<const bf16x8*>(a);
        bf16x8 b1 = *reinterpret_cast<const bf16x8*>(a + 32 * 256);
        p0 = __builtin_amdgcn_mfma_f32_32x32x16_bf16(b0, qr[d0], p0, 0, 0, 0);
        p1 = __builtin_amdgcn_mfma_f32_32x32x16_bf16(b1, qr[d0], p1, 0, 0, 0); }
}
template <int VB, bool SK>
__device__ __forceinline__ void pv_tile(f32x16* o, int vb0, bf16x8 pa0, bf16x8 pa1, bf16x8 pa2, bf16x8 pa3, bool act) {
    if (SK && !act) return;
#define TRRD(dst, off) asm volatile("ds_read_b64_tr_b16 %0, %1 offset:%2" : "=&v"(dst) : "v"(vb0), "i"(off) : "memory")
#define PV_D0(d0) do { s16x4 l0, l1, l2, l3, h0, h1, h2, h3; constexpr int b_ = VB * SHM_V + v_rd_off(d0, 0, 0);     \
        TRRD(l0, b_); TRRD(h0, b_ + 2048); TRRD(l1, b_ + 4096); TRRD(h1, b_ + 6144); TRRD(l2, b_ + 8192); TRRD(h2, b_ + 10240); TRRD(l3, b_ + 12288); TRRD(h3, b_ + 14336); \
        asm volatile("s_waitcnt lgkmcnt(0)" ::: "memory"); SBAR();                 \
        o[d0] = __builtin_amdgcn_mfma_f32_32x32x16_bf16(pa0, (bf16x8){l0[0], l0[1], l0[2], l0[3], h0[0], h0[1], h0[2], h0[3]}, o[d0], 0, 0, 0);   \
        o[d0] = __builtin_amdgcn_mfma_f32_32x32x16_bf16(pa1, (bf16x8){l1[0], l1[1], l1[2], l1[3], h1[0], h1[1], h1[2], h1[3]}, o[d0], 0, 0, 0);   \
        o[d0] = __builtin_amdgcn_mfma_f32_32x32x16_bf16(pa2, (bf16x8){l2[0], l2[1], l2[2], l2[3], h2[0], h2[1], h2[2], h2[3]}, o[d0], 0, 0, 0);   \
        o[d0] = __builtin_amdgcn_mfma_f32_32x32x16_bf16(pa3, (bf16x8){l3[0], l3[1], l3[2], l3[3], h3[0], h3[1], h3[2], h3[3]}, o[d0], 0, 0, 0); } while (0)
    PV_D0(0); PV_D0(1); PV_D0(2); PV_D0(3);
#undef PV_D0
#undef TRRD
}

template <class TIn, class TOut> struct BlockRef { const TIn* Q; const TIn* K; const TIn* V; TOut* O; int P0; const unsigned long long* MW; };
template <class TIn> struct Seam {
    bf16x8 qr[8];
    bf16x8 st_v0, st_v1, st_k0, st_k1; f32x4 sf0, sf1, sf2, sf3;
    f32x4 tq[16];
};
__device__ __forceinline__ int swa_jlo(int P0, int W) { const int lowk = P0 - W + 1; return lowk > 0 ? lowk / KVBLK : 0; }
#define ROW(p, k0, rr) ((p) + (size_t)((k0) + (rr)) * D + sc)
#define VMW() asm volatile("s_waitcnt vmcnt(0)" ::: "memory")
#define VMWN(n) asm volatile("s_waitcnt vmcnt(%0)" :: "i"(n) : "memory")
#define SLOAD_H(Kp, Vp, k0) do { S.st_v0 = load8<TIn>(ROW(Vp, k0, sr)); S.st_v1 = load8<TIn>(ROW(Vp, k0, 32 + sr));              \
                         S.st_k0 = load8<TIn>(ROW(Kp, k0, sr)); S.st_k1 = load8<TIn>(ROW(Kp, k0, 32 + sr)); } while (0)
#define SWRITE_HK(bf) do { *(bf16x8*)(K_lds + (bf) * SHM_K + kws) = S.st_k0; *(bf16x8*)(K_lds + (bf) * SHM_K + kws + 32 * 256) = S.st_k1; } while (0)
#define SWRITE_HV(bf) do { *(bf16x8*)(V_lds + (bf) * SHM_V + vst0) = S.st_v0; *(bf16x8*)(V_lds + (bf) * SHM_V + vst1) = S.st_v1; } while (0)
#define SWRITE_H(bf) do { SWRITE_HV(bf); SWRITE_HK(bf); } while (0)
#define SLOAD_F(p, k0) do { S.sf0 = *(const f32x4*)ROW(p, k0, sr); S.sf1 = *(const f32x4*)(ROW(p, k0, sr) + 4);                \
                            S.sf2 = *(const f32x4*)ROW(p, k0, 32 + sr); S.sf3 = *(const f32x4*)(ROW(p, k0, 32 + sr) + 4); } while (0)
#define SWRITE_KF(bf) do { *(bf16x8*)(K_lds + (bf) * SHM_K + kws) = pack8(S.sf0, S.sf1); *(bf16x8*)(K_lds + (bf) * SHM_K + kws + 32 * 256) = pack8(S.sf2, S.sf3); } while (0)
#define SWRITE_VF(bf) do { *(bf16x8*)(V_lds + (bf) * SHM_V + vst0) = pack8(S.sf0, S.sf1); *(bf16x8*)(V_lds + (bf) * SHM_V + vst1) = pack8(S.sf2, S.sf3); } while (0)
template <class TIn, class TOut>
__device__ __forceinline__ void causal_swa_prime(const BlockRef<TIn, TOut>& cur, int W, char* lds, Seam<TIn>& S) {
    constexpr bool F32 = same_t<TIn, float>::v;
    const int tid = threadIdx.x, wid = __builtin_amdgcn_readfirstlane(tid >> 6), lane = tid & 63, r32 = lane & 31, hi = lane >> 5;
    const int sr = tid >> 4, sc = (tid & 15) * 8, kws = KSWZ(sr, sc * 2); char* K_lds = lds + 2 * SHM_V;
    const int kb0 = swa_jlo(cur.P0, W) * KVBLK;
    for (int d0 = 0; d0 < 8; ++d0) S.qr[d0] = load8<TIn>(cur.Q + (size_t)(wid * QBLK + r32) * D + d0 * 16 + hi * 8);
    if constexpr (F32) { SLOAD_F((const float*)cur.K, kb0); VMW(); SWRITE_KF(0); SBAR(); SLOAD_F((const float*)cur.V, kb0); }
    else { SLOAD_H(cur.K, cur.V, kb0); VMW(); SWRITE_HK(0); }
    __syncthreads();
}
template <class TIn, class TOut>
__device__ __forceinline__ void causal_swa_block(const BlockRef<TIn, TOut>& cur, const BlockRef<TIn, TOut>& nxt, int skv, int W, char* lds, __attribute__((address_space(3))) unsigned char* lds_base3, Seam<TIn>& S) {
    constexpr bool F32 = same_t<TIn, float>::v;
    const int tid = threadIdx.x, wid = __builtin_amdgcn_readfirstlane(tid >> 6), lane = tid & 63, r32 = lane & 31, hi = lane >> 5;
    const int j_lo = swa_jlo(cur.P0, W);
    int j_hi = (cur.P0 + QB - 1) / KVBLK + 1; if (j_hi > skv / KVBLK) j_hi = skv / KVBLK;
    const int NT = j_hi - j_lo;
    const int kbn = swa_jlo(nxt.P0, W) * KVBLK;
    const int qlo = cur.P0 + wid * QBLK, qm = qlo + r32 - 4 * hi;
    char* V_lds = lds; char* K_lds = lds + 2 * SHM_V;
    float* ws = (float*)(lds + 2 * SHM_V + 2 * SHM_K) + wid * 64; float* li_l = ws, * al_l = ws + 32;
    float m_reg = -1e30f, l_reg = 0; f32x16 o[4] = {};
    const int sr = tid >> 4, sc = (tid & 15) * 8, vst0 = v_st(sr, sc), vst1 = v_st(32 + sr, sc), kws = KSWZ(sr, sc * 2);
    const int vb0 = (int)(uintptr_t)V_lds + v_rd_base(lane);
    const TIn* Kh = cur.K; const TIn* Vh = cur.V;
#define RESC(a) do { if (__any((a) < 1.f)) { if (hi == 0) al_l[r32] = (a); asm volatile("s_waitcnt lgkmcnt(0)" ::: "memory");              \
                     for (int d_ = 0; d_ < 4; ++d_) for (int r = 0; r < 16; ++r) o[d_][r] *= al_l[crow(r, hi)]; } } while (0)
#define KBASE(t) ((j_lo + (t)) * KVBLK)
#define ACT(t) (KBASE(t) <= qlo + QBLK - 1 && KBASE(t) + KVBLK - 1 >= qlo - W + 1)
#define LDW(t) (cur.MW[(size_t)(wid * QBLK + r32) * 32 + j_lo + (t)])
#define MASKT(P0_, P1_, W_, t) do { const int kb_ = KBASE(t); mask_bias_tile(P0_, P1_, W_, strip + (qm - kb_ - 59 + 256), hi); } while (0)
    constexpr int NQL = F32 ? 16 : 8;
    constexpr bool SK = WSKIP && !F32;
#define SEAM_K0() do { VMWN(NQL); if constexpr (F32) { SWRITE_KF(0); SBAR(); SLOAD_F((const float*)nxt.V, kbn); } else { SWRITE_HK(0); } SBAR(); } while (0)
    f32x16 pA0, pA1, pB0, pB1; float mnA, mnB, alA, alB; bf16x8 pa0, pa1, pa2, pa3;
    const __attribute__((address_space(3))) float* strip = (const __attribute__((address_space(3))) float*)(lds_base3 + STRIP_OFF);
    unsigned long long wA = LDW(0), wB = NT > 1 ? LDW(1) : 0ull;
    if constexpr (F32) { VMW(); SWRITE_VF(0); SBAR(); } else { SWRITE_HV(0); SBAR(); }
    if (NT > 1) { if constexpr (F32) SLOAD_F((const float*)Kh, KBASE(1)); else SLOAD_H(Kh, Vh, KBASE(1)); }
    SBAR(); qkt<0, SK>(pA0, pA1, K_lds, r32, hi, S.qr, ACT(0));
    if constexpr (F32) { if (NT > 1) { VMW(); SWRITE_KF(1); SBAR(); SLOAD_F((const float*)Vh, KBASE(1)); } }
    MASKT(pA0, pA1, wA, 0); partialSM(pA0, pA1, m_reg, mnA, alA);
    if (NT > 1) { VMW(); if constexpr (F32) { SWRITE_VF(1); SBAR(); if (NT > 2) SLOAD_F((const float*)Kh, KBASE(2)); } else SWRITE_H(1); }
    __syncthreads();
#define HALF_STEP(PX0, PX1, mnX, alX, PY0, PY1, alY, WX, WY, t, KB, VB, SB) do {                                                      \
        if ((t) + 1 < NT) WY = LDW((t) + 1);                                                                                  \
        SBAR(); qkt<KB, SK>(PX0, PX1, K_lds, r32, hi, S.qr, ACT(t));                                             \
        finishSM(PY0, PY1, alY, l_reg, pa0, pa1, pa2, pa3); SBAR();                                                           \
        if ((t) + 1 < NT) { if constexpr (F32) { VMW(); SWRITE_KF(SB); SBAR(); SLOAD_F((const float*)Vh, KBASE((t) + 1)); }  \
                            else { SLOAD_H(Kh, Vh, KBASE((t) + 1)); } SBAR(); }                                               \
        pv_tile<VB, SK>(o, vb0, pa0, pa1, pa2, pa3, ACT((t) - 1)); MASKT(PX0, PX1, WX, (t)); partialSM(PX0, PX1, m_reg, mnX, alX);                                        \
        __syncthreads();                                                                                                      \
        if ((t) + 1 < NT) { VMW(); if constexpr (F32) { SWRITE_VF(SB); SBAR(); if ((t) + 2 < NT) SLOAD_F((const float*)Kh, KBASE((t) + 2)); } \
                            else { SWRITE_H(SB); } }                                                                          \
        RESC(alX); __syncthreads(); } while (0)
    for (int t = 1; t + 1 < NT; t += 2) {
        HALF_STEP(pB0, pB1, mnB, alB, pA0, pA1, alA, wB, wA, t, 1, 0, 0);
        HALF_STEP(pA0, pA1, mnA, alA, pB0, pB1, alB, wA, wB, t + 1, 0, 1, 1);
    }
    const bool even = (NT & 1) == 0;
    if (even) { SBAR(); qkt<1, SK>(pB0, pB1, K_lds, r32, hi, S.qr, ACT(NT - 1)); SBAR(); }
#define QROW(e) (nxt.Q + (size_t)(wid * QBLK + r32) * D + ((e) >> 1) * 16 + hi * 8 + ((e) & 1) * 4)
    if constexpr (F32) { SLOAD_F((const float*)nxt.K, kbn); SBAR();
#pragma unroll
        for (int e = 0; e < 8; ++e) S.tq[e] = *(const f32x4*)QROW(e); }
    else { SLOAD_H(nxt.K, nxt.V, kbn); SBAR();
#pragma unroll
        for (int d0 = 0; d0 < 8; ++d0) S.qr[d0] = load8<TIn>(nxt.Q + (size_t)(wid * QBLK + r32) * D + d0 * 16 + hi * 8); }
    SBAR();
    finishSM(pA0, pA1, alA, l_reg, pa0, pa1, pa2, pa3); SBAR();
    if constexpr (F32) {
#pragma unroll
        for (int e = 8; e < 16; ++e) S.tq[e] = *(const f32x4*)QROW(e); SBAR(); }
#undef QROW
    pv_tile<0, SK>(o, vb0, pa0, pa1, pa2, pa3, ACT(even ? NT - 2 : NT - 1));
    if (even) { MASKT(pB0, pB1, wB, NT - 1); partialSM(pB0, pB1, m_reg, mnB, alB); __syncthreads(); RESC(alB);
        finishSM(pB0, pB1, alB, l_reg, pa0, pa1, pa2, pa3); SBAR(); pv_tile<1, SK>(o, vb0, pa0, pa1, pa2, pa3, ACT(NT - 1)); }
    SBAR(); SEAM_K0();
    if (hi == 0) li_l[r32] = l_reg; asm volatile("s_waitcnt lgkmcnt(0)" ::: "memory");
    float rli[16];
#pragma unroll
    for (int r = 0; r < 16; ++r) rli[r] = __builtin_amdgcn_rcpf(li_l[crow(r, hi)]);
    TOut* Ow = cur.O + (size_t)(wid * QBLK) * OSTR;
#pragma unroll
    for (int r = 0; r < 16; ++r) { const int orow = crow(r, hi);
#pragma unroll
        for (int d0 = 0; d0 < 4; ++d0) { const float v = o[d0][r] * rli[r];
            if constexpr (same_t<TOut, float>::v) { Ow[(size_t)orow * OSTR + d0 * 32 + r32] = v; }
            else { const float vn = __shfl_xor(v, 1);
                   if ((r32 & 1) == 0) *(unsigned*)(Ow + (size_t)orow * OSTR + d0 * 32 + r32) = cvtpk(v, vn); } } }
    if constexpr (F32) {
#pragma unroll
        for (int d0 = 0; d0 < 8; ++d0) S.qr[d0] = pack8(S.tq[2 * d0], S.tq[2 * d0 + 1]); }
    __syncthreads();
#undef RESC
#undef KBASE
#undef ACT
#undef MASKT
#undef LDW
#undef SEAM_K0
#undef HALF_STEP
}
#undef ROW
#undef VMW
#undef VMWN
#undef SLOAD_H
#undef SWRITE_HK
#undef SWRITE_HV
#undef SWRITE_H
#undef SLOAD_F
#undef SWRITE_KF
#undef SWRITE_VF

}

constexpr int NWAVES = 8;
constexpr int NPH = 10;
constexpr int N_LAUNCHES = MK_N_LAUNCHES;
static_assert(N_LAUNCHES == 1 || N_LAUNCHES == NPH, "MK_N_LAUNCHES is 1 or 10");
constexpr int RING_OFF = 0, RING_BYTES = 131072;
constexpr int LDSCTL_OFF = RING_BYTES, MISC_OFF = LDSCTL_OFF + 320;
constexpr int LDS_BYTES = 147456;
static_assert(MISC_OFF + 128 <= LDS_BYTES, "LDS map");

constexpr size_t MiB = 1u << 20;
constexpr size_t al1(size_t x) { return (x + MiB - 1) / MiB * MiB; }
constexpr size_t WS_CTL = 0, CTL_ZERO_BYTES = 1 * MiB;
constexpr size_t WS_WINT = 2 * MiB;
constexpr size_t WS_WPAT = WS_WINT + al1((size_t)NINP * D * 2);
constexpr size_t WS_WPBT = WS_WPAT + al1((size_t)D * AW * 2);
constexpr size_t WS_WOT  = WS_WPBT + al1((size_t)D * CWD * 2);
constexpr size_t WS_W1T  = WS_WOT  + al1((size_t)D * D * 2);
constexpr size_t WS_W2T  = WS_W1T  + al1((size_t)FF * D * 2);
constexpr size_t WS_H    = WS_W2T  + al1((size_t)D * FF * 2);
constexpr size_t WS_QH   = WS_H    + al1((size_t)MPAD * D * 2);
constexpr size_t WS_KH   = WS_QH   + al1((size_t)MPR * AW * 2);
constexpr size_t WS_VH   = WS_KH   + al1((size_t)MPR * AW * 2);
constexpr size_t WS_QI   = WS_VH   + al1((size_t)MPR * AW * 2);
static_assert(WS_KH - WS_QH == (size_t)MPR * AW * 2 && WS_VH - WS_KH == (size_t)MPR * AW * 2, "QH | KH | VH contiguous");
constexpr size_t WS_KIB  = WS_QI   + al1((size_t)MPAD * 1024 * 2);
constexpr size_t WS_WI   = WS_KIB  + al1((size_t)MPAD * IDM * 2);
constexpr size_t WS_CXB  = WS_WI   + al1((size_t)MPAD * IH * 4);
constexpr size_t WS_SGA  = WS_CXB  + al1((size_t)3 * MPAD * CWD * 2);
constexpr size_t WS_SGB  = WS_SGA  + al1((size_t)MPAD * D * 2);
constexpr size_t WS_MASK = WS_SGB  + al1((size_t)MPAD * D * 2);
constexpr size_t WS_ATT  = WS_MASK + al1((size_t)MPR * 32 * 8);
constexpr size_t WS_CBY  = WS_ATT  + al1((size_t)MPAD * AW * 2);
constexpr size_t WS_MX   = WS_CBY  + al1((size_t)MPAD * CWD * 2);
constexpr size_t WS_X2   = WS_MX   + al1((size_t)MPAD * D * 2);
constexpr size_t WS_XB   = WS_X2   + al1((size_t)MPAD * D * 4);
constexpr size_t WS_HID  = WS_XB   + al1((size_t)MPAD * D * 2);
constexpr size_t WS_QS   = WS_HID  + al1((size_t)MPAD * FF * 2);
constexpr size_t WS_SSC  = WS_QS   + al1((size_t)MS * AW * 4);
constexpr size_t WS_SEL  = WS_SSC  + al1((size_t)MS * SSTR * 4);
constexpr size_t WS_END  = WS_SEL  + al1((size_t)MS * TOPK * 4);
constexpr int CW_TMO = 0, CW_CODE = 1;
constexpr int CW_BAR = 4096;
constexpr int CW_SSQ1 = 16384, CW_SSQ2 = 32768;
static_assert((CW_SSQ2 + MPAD) * 4 <= (int)CTL_ZERO_BYTES && CW_BAR + 3456 <= CW_SSQ1 && CW_SSQ1 + MPAD <= CW_SSQ2, "CTL map");

struct Frame {
    LAS unsigned char* lds;
    volatile LAS unsigned* MISC;
    gu32* ctl;
    int tid, lane, wave, vcu, G;
};

__device__ __forceinline__ float wave_sum(float v) {
#pragma unroll
    for (int o = 1; o < 64; o <<= 1) v += __shfl_xor(v, o);
    return v;
}

template <int MODE>
__device__ __forceinline__ void p0_transpose_item(const float* W, int K, int Nsrc, int Ndst, bf16* WT, const float* g, LAS float* scr, int item, int lane) {
    const int nblk = Ndst / 32, kb = item / nblk, nb = item % nblk, k0 = 64 * kb, n0 = 32 * nb;
    const int n = n0 + (lane & 31);
    int src = n; if (MODE == 1) src = n < 4176 ? n : (n >= 4352 ? n - 176 : -1);
#pragma unroll 8
    for (int i = 0; i < 32; ++i) { const int kk = 2 * i + (lane >> 5); float v = 0.f; if (src >= 0) v = W[(size_t)(k0 + kk) * Nsrc + src]; if (MODE == 2) v *= g[k0 + kk]; scr[kk * 33 + (lane & 31)] = v; }
    LDS_WAIT(); asm volatile("" ::: "memory");
    const int c = lane & 7;
#pragma unroll
    for (int j = 0; j < 4; ++j) { const int nn = (lane >> 3) + 8 * j; const LAS float* s = scr + (8 * c) * 33 + nn;
        v4u o; o.x = cvt_pk_bf16(s[0 * 33], s[1 * 33]); o.y = cvt_pk_bf16(s[2 * 33], s[3 * 33]); o.z = cvt_pk_bf16(s[4 * 33], s[5 * 33]); o.w = cvt_pk_bf16(s[6 * 33], s[7 * 33]);
        *(GAS v4u*)(WT + (size_t)(n0 + nn) * K + k0 + 8 * c) = o; }
    LDS_WAIT(); asm volatile("" ::: "memory");
}
__device__ __forceinline__ void rms_row_to_bf16(const float* xrow, const float* g, bf16* orow, int lane) {
    const GAS f32x4* xr = (const GAS f32x4*)xrow + lane; const GAS f32x4* gr = (const GAS f32x4*)g + lane;
    f32x4 v[8]; float s = 0.f;
#pragma unroll
    for (int j = 0; j < 8; ++j) { v[j] = xr[64 * j]; s += (v[j].x * v[j].x + v[j].y * v[j].y) + (v[j].z * v[j].z + v[j].w * v[j].w); }
    const float rs = 1.0f / sqrtf(wave_sum(s) * (1.0f / D) + EPS);
    GAS v2u* o8 = (GAS v2u*)orow + lane;
#pragma unroll
    for (int j = 0; j < 8; ++j) { const f32x4 gg = gr[64 * j]; v2u w; w.x = cvt_pk_bf16(v[j].x * rs * gg.x, v[j].y * rs * gg.y); w.y = cvt_pk_bf16(v[j].z * rs * gg.z, v[j].w * rs * gg.w); o8[64 * j] = w; }
}
struct P0Args { const float *xp, *xs, *gmix, *win, *wpa, *wpb, *wo, *gmlp, *w1, *w2; bf16 *WinT, *WpaT, *WpbT, *WoT, *W1T, *W2T, *H; };
__device__ __forceinline__ void p0_prologue(Frame& F, const P0Args& a) {
    LAS float* scr = (LAS float*)(F.lds + RING_OFF + F.wave * 16384);
    const int gw = F.vcu * NWAVES + F.wave, NGW = F.G * NWAVES;
    constexpr int I_IN = (D / 64) * (NINP / 32), I_PA = (AW / 64) * (D / 32), I_PB = (CWD / 64) * (D / 32), I_O = (D / 64) * (D / 32), I_1 = (D / 64) * (FF / 32), I_2 = (FF / 64) * (D / 32);
    constexpr int NITEMS = I_IN + I_PA + I_PB + I_O + I_1 + I_2;
    for (int it = gw; it < NITEMS; it += NGW) {
        int r = it;
        if (r < I_IN) { p0_transpose_item<1>(a.win, D, NIN, NINP, a.WinT, nullptr, scr, r, F.lane); continue; } r -= I_IN;
        if (r < I_PA) { p0_transpose_item<0>(a.wpa, AW, D, D, a.WpaT, nullptr, scr, r, F.lane); continue; } r -= I_PA;
        if (r < I_PB) { p0_transpose_item<0>(a.wpb, CWD, D, D, a.WpbT, nullptr, scr, r, F.lane); continue; } r -= I_PB;
        if (r < I_O)  { p0_transpose_item<0>(a.wo, D, D, D, a.WoT, nullptr, scr, r, F.lane); continue; } r -= I_O;
        if (r < I_1)  { p0_transpose_item<2>(a.w1, D, FF, FF, a.W1T, a.gmlp, scr, r, F.lane); continue; } r -= I_1;
        p0_transpose_item<0>(a.w2, FF, D, D, a.W2T, nullptr, scr, r, F.lane);
    }
    for (int m = gw; m < MPAD; m += NGW) {
        if (m < MPR) rms_row_to_bf16(a.xp + (size_t)m * D, a.gmix, a.H + (size_t)m * D, F.lane);
        else if (m < MTOT) rms_row_to_bf16(a.xs + (size_t)(m - MPR) * D, a.gmix, a.H + (size_t)m * D, F.lane);
        else { GAS v4u* o = (GAS v4u*)(a.H + (size_t)m * D) + F.lane;
#pragma unroll
            for (int j = 0; j < 4; ++j) o[64 * j] = (v4u){0u, 0u, 0u, 0u}; }
    }
}

__device__ __forceinline__ int rel_bucket(int n) {
    if (n < 16) return n < 0 ? 0 : n;
    int l = 16 + (int)(logf((float)n * (1.0f / 16.0f)) / 2.0794415416798357f * 16.0f);
    return l > 31 ? 31 : l;
}

__device__ __forceinline__ unsigned mono_key(float f) { const unsigned u = __float_as_uint(f); return (u & 0x80000000u) ? ~u : (u | 0x80000000u); }
__device__ __forceinline__ void idx_unit(LAS unsigned char* lds, const bf16* QI, const bf16* KIB, const float* WI, u64* MASKW, int b, int blk, int tid, int wid, int lane) {
    const int t0 = blk * 16 + 2 * wid, r = lane & 31, hf = lane >> 5;
    const int tokA = (r >> 2) & 1, headA = (r & 3) + 4 * (r >> 3);
    const bf16* qp = QI + (size_t)(b * T + t0 + tokA) * 1024 + headA * IDM + 8 * hf;
    bf16x8 af[4];
#pragma unroll
    for (int i = 0; i < 4; ++i) af[i] = *(const bf16x8*)(qp + 16 * i);
    const float* wp = WI + (size_t)(b * T + t0 + hf) * IH;
    f32x4 w4[4];
#pragma unroll
    for (int i = 0; i < 4; ++i) w4[i] = *(const f32x4*)(wp + 4 * i);
    const int nkeys = blk * 16 + 16, nch = (nkeys + 255) >> 8;
    const int ntw = ((t0 + 1) >> 5) + 1;
    const int tme = t0 + hf;
    unsigned skey[64];
    const bf16* kbase = KIB + (size_t)b * T * IDM;
    v4u st[4];
#pragma unroll
    for (int i = 0; i < 4; ++i) st[i] = *(const v4u*)(kbase + (size_t)(tid + 512 * i) * 8);
#pragma unroll
    for (int i = 0; i < 4; ++i) { const int p = tid + 512 * i, key = p >> 3, c16 = p & 7; *(LAS v4u*)(lds + key * 128 + ((c16 ^ (key & 7)) << 4)) = st[i]; }
    __syncthreads();
#pragma unroll
    for (int c = 0; c < 8; ++c) {
        if (c < nch) {
            if (c + 1 < nch) {
#pragma unroll
                for (int i = 0; i < 4; ++i) st[i] = *(const v4u*)(kbase + (size_t)(c + 1) * 256 * IDM + (size_t)(tid + 512 * i) * 8);
            }
            const LAS unsigned char* kb = lds + (c & 1) * 32768;
#pragma unroll
            for (int jt = 0; jt < 8; ++jt) { const int j = 8 * c + jt;
                if (j < ntw) {
                    const int kl = 32 * jt + r;
                    bf16x8 bfr[4];
#pragma unroll
                    for (int i = 0; i < 4; ++i) bfr[i] = *(const LAS bf16x8*)(kb + kl * 128 + (((2 * i + hf) ^ (kl & 7)) << 4));
                    f32x16 acc = {};
#pragma unroll
                    for (int i = 0; i < 4; ++i) acc = __builtin_amdgcn_mfma_f32_32x32x16_bf16(af[i], bfr[i], acc, 0, 0, 0);
                    float s0 = 0.f, s1 = 0.f;
#pragma unroll
                    for (int q = 0; q < 4; ++q) { s0 = fmaf(w4[q][0], fmaxf(acc[4 * q + 0], 0.f), s0); s1 = fmaf(w4[q][1], fmaxf(acc[4 * q + 1], 0.f), s1);
                                                  s0 = fmaf(w4[q][2], fmaxf(acc[4 * q + 2], 0.f), s0); s1 = fmaf(w4[q][3], fmaxf(acc[4 * q + 3], 0.f), s1); }
                    const int key = 32 * j + r;
                    skey[j] = key <= tme ? mono_key(s0 + s1) : 0u;
                } else skey[j] = 0u;
            }
            if (c + 1 < nch) {
#pragma unroll
                for (int i = 0; i < 4; ++i) { const int p = tid + 512 * i, key = p >> 3, c16 = p & 7; *(LAS v4u*)(lds + ((c + 1) & 1) * 32768 + key * 128 + ((c16 ^ (key & 7)) << 4)) = st[i]; }
            }
            __syncthreads();
        } else {
#pragma unroll
            for (int jt = 0; jt < 8; ++jt) skey[8 * c + jt] = 0u;
        }
    }
    unsigned prefix = 0u;
    if (t0 + 1 >= TOPK) {
        for (int bit = 31; bit >= 0; --bit) {
            const unsigned cand = prefix | (1u << bit);
            int cA = 0, cB = 0;
#pragma unroll
            for (int j = 0; j < 64; ++j) if (j < ntw) { const u64 mm = __ballot(skey[j] >= cand); cA += __popc((unsigned)mm); cB += __popc((unsigned)(mm >> 32)); }
            const int cnt = hf ? cB : cA;
            if (cnt >= TOPK) prefix = cand;
        }
    }
    const unsigned theta = (tme < TOPK) ? 1u : prefix;
    u64* mwA = MASKW + (size_t)(b * T + t0) * 32; u64* mwB = mwA + 32;
#pragma unroll
    for (int j2 = 0; j2 < 32; ++j2) {
        u64 m0 = 0, m1 = 0;
        if (2 * j2 < ntw) m0 = __ballot(skey[2 * j2] >= theta);
        if (2 * j2 + 1 < ntw) m1 = __ballot(skey[2 * j2 + 1] >= theta);
        const u64 wA = (m0 & 0xffffffffull) | (m1 << 32), wB = (m0 >> 32) | (m1 & 0xffffffff00000000ull);
        if (lane == 0) mwA[j2] = wA;
        if (lane == 32) mwB[j2] = wB;
    }
}

__device__ __forceinline__ void sidx_tile(const bf16x8 (&af)[2][4], const float* kr, bool f32src, const bf16* krb, const f32x4 (&w4)[2][4], float (&sc)[2], int hf) {
    bf16x8 bfr[4];
#pragma unroll
    for (int i = 0; i < 4; ++i) {
        if (f32src) { const f32x4 a = *(const f32x4*)(kr + 16 * i + 8 * hf), c = *(const f32x4*)(kr + 16 * i + 8 * hf + 4); const v4u p = pack8(a, c); bfr[i] = *(const bf16x8*)&p; }
        else bfr[i] = *(const bf16x8*)(krb + 16 * i + 8 * hf);
    }
#pragma unroll
    for (int pr = 0; pr < 2; ++pr) {
        f32x16 acc = {};
#pragma unroll
        for (int i = 0; i < 4; ++i) acc = __builtin_amdgcn_mfma_f32_32x32x16_bf16(af[pr][i], bfr[i], acc, 0, 0, 0);
        float s0 = 0.f, s1 = 0.f;
#pragma unroll
        for (int q = 0; q < 4; ++q) { s0 = fmaf(w4[pr][q][0], fmaxf(acc[4 * q + 0], 0.f), s0); s1 = fmaf(w4[pr][q][1], fmaxf(acc[4 * q + 1], 0.f), s1);
                                      s0 = fmaf(w4[pr][q][2], fmaxf(acc[4 * q + 2], 0.f), s0); s1 = fmaf(w4[pr][q][3], fmaxf(acc[4 * q + 3], 0.f), s1); }
        sc[pr] = s0 + s1;
    }
}
__device__ __forceinline__ void sidx_unit(const bf16* QI, const bf16* KIB, const float* WI, const float* ckidx, const int* ptab, float* SSC, int b, int chunk, int wid, int lane) {
    const int r = lane & 31, hf = lane >> 5;
    const int tokA = (r >> 2) & 1, headA = (r & 3) + 4 * (r >> 3);
    bf16x8 af[2][4]; f32x4 w4[2][4];
#pragma unroll
    for (int pr = 0; pr < 2; ++pr) {
        const bf16* qp = QI + (size_t)(MPR + b * DT + 2 * pr + tokA) * 1024 + headA * IDM + 8 * hf;
        const float* wp = WI + (size_t)(MPR + b * DT + 2 * pr + hf) * IH;
#pragma unroll
        for (int i = 0; i < 4; ++i) { af[pr][i] = *(const bf16x8*)(qp + 16 * i); w4[pr][i] = *(const f32x4*)(wp + 4 * i); }
    }
#pragma unroll
    for (int tl = 0; tl < 2; ++tl) {
        const int s = chunk * 512 + wid * 64 + tl * 32 + r;
        const int phys = ptab[b * NPAGES + (s >> 7)];
        const float* kr = ckidx + ((size_t)phys * PAGE + (s & 127)) * IDM;
        float sc[2];
        sidx_tile(af, kr, true, nullptr, w4, sc, hf);
        SSC[(size_t)(b * DT + hf) * SSTR + s] = sc[0];
        SSC[(size_t)(b * DT + 2 + hf) * SSTR + s] = sc[1];
    }
    if (chunk == 0 && wid == 0) {
        const int n = r < DT ? r : DT - 1;
        float sc[2];
        sidx_tile(af, nullptr, false, KIB + (size_t)(MPR + b * DT + n) * IDM, w4, sc, hf);
        if (r < DT) { SSC[(size_t)(b * DT + hf) * SSTR + PAST + r] = sc[0]; SSC[(size_t)(b * DT + 2 + hf) * SSTR + PAST + r] = sc[1]; }
    }
}

struct ConvArgs { const bf16* CXB; const float* convw; const float* sconv; bf16* CBY; float* out; };
__device__ __forceinline__ void unpack8(const v4u w, float (&f)[8]) { f[0] = bf_lo(w.x); f[1] = bf_hi(w.x); f[2] = bf_lo(w.y); f[3] = bf_hi(w.y); f[4] = bf_lo(w.z); f[5] = bf_hi(w.z); f[6] = bf_lo(w.w); f[7] = bf_hi(w.w); }
__device__ __forceinline__ void conv_items(Frame& F, const ConvArgs& a) {
    const bf16* CX = a.CXB; const bf16* CB = a.CXB + (size_t)MPAD * CWD; const bf16* CC = a.CXB + (size_t)2 * MPAD * CWD;
    const long gt = (long)F.vcu * 512 + F.tid, NGT = (long)F.G * 512;
    for (long it = gt; it < (long)MTOT * 128; it += NGT) {
        const int row = (int)(it >> 7), c0 = (int)(it & 127) * 8;
        float w0[8], w1[8], w2[8];
#pragma unroll
        for (int j = 0; j < 8; ++j) { w0[j] = a.convw[c0 + j]; w1[j] = a.convw[CWD + c0 + j]; w2[j] = a.convw[2 * CWD + c0 + j]; }
        float u[3][8];
        const bool samp = row >= MPR; const int tt = samp ? ((row - MPR) & (DT - 1)) : (row & (T - 1));
#pragma unroll
        for (int k = 0; k < 3; ++k) {
            const int ts = tt - 2 + k;
            if (ts >= 0) { float a8[8], b8[8]; unpack8(*(const v4u*)(CX + (size_t)(row - 2 + k) * CWD + c0), a8); unpack8(*(const v4u*)(CC + (size_t)(row - 2 + k) * CWD + c0), b8);
#pragma unroll
                for (int j = 0; j < 8; ++j) u[k][j] = a8[j] * b8[j]; }
            else if (samp) { const int bb = (row - MPR) >> 2; const float* sp = a.sconv + ((size_t)bb * 2 + (ts + 2)) * CWD + c0;
#pragma unroll
                for (int j = 0; j < 8; ++j) u[k][j] = sp[j]; }
            else {
#pragma unroll
                for (int j = 0; j < 8; ++j) u[k][j] = 0.f; }
        }
        float cb8[8]; unpack8(*(const v4u*)(CB + (size_t)row * CWD + c0), cb8);
        f32x4 y0, y1;
#pragma unroll
        for (int j = 0; j < 4; ++j) { y0[j] = cb8[j] * (w0[j] * u[0][j] + w1[j] * u[1][j] + w2[j] * u[2][j]); y1[j] = cb8[4 + j] * (w0[4 + j] * u[0][4 + j] + w1[4 + j] * u[1][4 + j] + w2[4 + j] * u[2][4 + j]); }
        *(v4u*)(a.CBY + (size_t)row * CWD + c0) = pack8(y0, y1);
        float* so = nullptr;
        if (!samp) { if (tt >= T - 2) so = a.out + OUT_CONV + ((size_t)(row >> 11) * 2 + (tt - (T - 2))) * CWD + c0; }
        else if (tt >= DT - 2) so = a.out + OUT_CONVS + ((size_t)((row - MPR) >> 2) * 2 + (tt - (DT - 2))) * CWD + c0;
        if (so) {
#pragma unroll
            for (int j = 0; j < 8; ++j) so[j] = u[2][j]; }
    }
}

__device__ __forceinline__ void ssel_unit(LAS unsigned char* lds, const float* SSC, int* SEL, int q, int tid, int wid, int lane) {
    LAS int* cw = (LAS int*)lds;
    const int tq = q & (DT - 1);
    unsigned v[33];
#pragma unroll
    for (int i = 0; i < 33; ++i) { const int idx = tid + 512 * i; unsigned k = 0u;
        if (idx < PAST || (idx < NKS && idx - PAST <= tq)) k = mono_key(SSC[(size_t)q * SSTR + idx]);
        v[i] = k; }
    unsigned prefix = 0u;
    for (int bit = 31; bit >= 0; --bit) {
        const unsigned cand = prefix | (1u << bit);
        int c = 0;
#pragma unroll
        for (int i = 0; i < 33; ++i) c += __popcll(__ballot(v[i] >= cand));
        const int par = bit & 1;
        if (lane == 0) cw[par * 8 + wid] = c;
        __syncthreads();
        int tot = 0;
#pragma unroll
        for (int w = 0; w < 8; ++w) tot += cw[par * 8 + w];
        if (tot >= TOPK) prefix = cand;
    }
    const unsigned theta = prefix;
    int mycnt = 0;
#pragma unroll
    for (int i = 0; i < 33; ++i) mycnt += __popcll(__ballot(v[i] >= theta));
    __syncthreads();
    if (lane == 0) cw[64 + wid] = mycnt;
    __syncthreads();
    int base = 0;
#pragma unroll
    for (int w = 0; w < 8; ++w) if (w < wid) base += cw[64 + w];
    const u64 ltmask = (1ull << lane) - 1ull;
#pragma unroll
    for (int i = 0; i < 33; ++i) { const u64 mm = __ballot(v[i] >= theta);
        if (v[i] >= theta) { const int pos = base + __popcll(mm & ltmask); if (pos < TOPK) SEL[q * TOPK + pos] = tid + 512 * i; }
        base += __popcll(mm); }
    __syncthreads();
}

struct SAttArgs { const float *QS, *knew, *vnew, *ck, *cv, *relb; const int *ptab, *SEL; bf16* ATT; };
__device__ __forceinline__ void satt_unit(LAS unsigned char* lds, const SAttArgs& a, int q, int h, int tid, int wid, int lane) {
    LAS float* lg = (LAS float*)lds;
    LAS float* red = lg + 256;
    LAS float* part = lg + 512;
    LAS int* rowoff = (LAS int*)(lg + 1024);
    const int b = q >> 2, tq = q & 3, qpos = PAST + tq;
    if (tid < TOPK) { const int s = a.SEL[q * TOPK + tid]; int ro;
        if (s < PAST) ro = a.ptab[b * NPAGES + (s >> 7)] * PAGE + (s & 127); else ro = -(1 + (s - PAST));
        rowoff[tid] = ro;
        lg[tid] = a.relb[rel_bucket(qpos - s) * NH + h]; }
    __syncthreads();
    const int l16 = lane & 15, kq = lane >> 4;
    const f32x4 q0 = *(const f32x4*)(a.QS + (size_t)q * AW + h * HD + 8 * l16), q1 = *(const f32x4*)(a.QS + (size_t)q * AW + h * HD + 8 * l16 + 4);
#pragma unroll
    for (int i = 0; i < 8; ++i) { const int k = 32 * wid + 4 * i + kq; const int ro = rowoff[k];
        const float* kr = ro >= 0 ? a.ck + ((size_t)ro * NH + h) * HD : a.knew + ((size_t)(b * DT + (-ro - 1))) * AW + h * HD;
        const f32x4 k0 = *(const f32x4*)(kr + 8 * l16), k1 = *(const f32x4*)(kr + 8 * l16 + 4);
        float d = (q0[0] * k0[0] + q0[1] * k0[1]) + (q0[2] * k0[2] + q0[3] * k0[3]) + (q1[0] * k1[0] + q1[1] * k1[1]) + (q1[2] * k1[2] + q1[3] * k1[3]);
        d += __shfl_xor(d, 1); d += __shfl_xor(d, 2); d += __shfl_xor(d, 4); d += __shfl_xor(d, 8);
        if (l16 == 0) lg[k] = lg[k] + d * 0.08838834764831845f; }
    __syncthreads();
    float mx = fmaxf(fmaxf(lg[lane], lg[lane + 64]), fmaxf(lg[lane + 128], lg[lane + 192]));
#pragma unroll
    for (int o = 1; o < 64; o <<= 1) mx = fmaxf(mx, __shfl_xor(mx, o));
    const float e0 = __expf(lg[lane] - mx), e1 = __expf(lg[lane + 64] - mx), e2 = __expf(lg[lane + 128] - mx), e3 = __expf(lg[lane + 192] - mx);
    const float ssum = wave_sum((e0 + e1) + (e2 + e3));
    __syncthreads();
    if (wid == 0) { lg[lane] = e0; lg[lane + 64] = e1; lg[lane + 128] = e2; lg[lane + 192] = e3; }
    __syncthreads();
    const int g = tid >> 7, d = tid & 127; float o = 0.f;
#pragma unroll 8
    for (int k = 64 * g; k < 64 * g + 64; ++k) { const int ro = rowoff[k];
        const float* vr = ro >= 0 ? a.cv + ((size_t)ro * NH + h) * HD : a.vnew + ((size_t)(b * DT + (-ro - 1))) * AW + h * HD;
        o = fmaf(lg[k], vr[d], o); }
    part[g * 128 + d] = o;
    __syncthreads();
    if (tid < 128) { const float r = ((part[tid] + part[128 + tid]) + (part[256 + tid] + part[384 + tid])) / ssum;
        a.ATT[(size_t)(MPR + q) * AW + h * HD + tid] = (bf16)(cvt_pk_bf16(r, 0.f) & 0xffffu); }
    __syncthreads();
    (void)red;
}

__device__ __forceinline__ void final_norm(Frame& F, float* out, const float* SSQ2, const float* gf) {
    const int gw = F.vcu * NWAVES + F.wave, NGW = F.G * NWAVES;
    for (int m = gw; m < MTOT; m += NGW) {
        float* row = m < MPR ? out + OUT_Y + (size_t)m * D : out + OUT_YS + (size_t)(m - MPR) * D;
        const float rs = 1.0f / sqrtf(__hip_atomic_load(SSQ2 + m, RLX_AGENT) * (1.0f / D) + EPS);
        GAS f32x4* xr = (GAS f32x4*)row + F.lane; const GAS f32x4* gr = (const GAS f32x4*)gf + F.lane;
#pragma unroll
        for (int j = 0; j < 8; ++j) { const f32x4 v = xr[64 * j], gg = gr[64 * j]; xr[64 * j] = v * rs * gg; }
    }
}

struct Args { const void* in[18]; float* out; unsigned char* ws; int ph_lo, ph_hi; };

template <int PH_LO, int PH_HI>
__global__ void __launch_bounds__(NWAVES * 64, 2) fwd(Args args) {
    extern __shared__ __attribute__((aligned(16))) unsigned char lds[];
    Frame F;
    F.lds = (LAS unsigned char*)lds;
    F.MISC = (volatile LAS unsigned*)(F.lds + MISC_OFF);
    F.tid = threadIdx.x; F.lane = F.tid & 63; F.wave = __builtin_amdgcn_readfirstlane(F.tid >> 6);
    F.G = gridDim.x; { const int bx = blockIdx.x; F.vcu = (F.G % 8 == 0) ? (bx % 8) * (F.G / 8) + bx / 8 : bx; }
    F.ctl = (gu32*)(args.ws + WS_CTL);
#define x_prompt ((const float*)args.in[0])
#define x_sample ((const float*)args.in[1])
#define cache_k ((const float*)args.in[2])
#define cache_v ((const float*)args.in[3])
#define cache_kidx ((const float*)args.in[4])
#define state_conv ((const float*)args.in[5])
#define page_table ((const int*)args.in[6])
#define rel_bias ((const float*)args.in[7])
#define norm_mix_g ((const float*)args.in[8])
#define w_in ((const float*)args.in[9])
#define conv_w ((const float*)args.in[10])
#define w_pa ((const float*)args.in[11])
#define w_pb ((const float*)args.in[12])
#define w_o ((const float*)args.in[13])
#define norm_mlp_g ((const float*)args.in[14])
#define w_mlp_in ((const float*)args.in[15])
#define w_mlp_out ((const float*)args.in[16])
#define norm_final_g ((const float*)args.in[17])
#define out (args.out)
#define WinT ((bf16*)(args.ws + WS_WINT))
#define WpaT ((bf16*)(args.ws + WS_WPAT))
#define WpbT ((bf16*)(args.ws + WS_WPBT))
#define WoT ((bf16*)(args.ws + WS_WOT))
#define W1T ((bf16*)(args.ws + WS_W1T))
#define W2T ((bf16*)(args.ws + WS_W2T))
#define HBUF ((bf16*)(args.ws + WS_H))
#define QH ((bf16*)(args.ws + WS_QH))
#define KH ((bf16*)(args.ws + WS_KH))
#define VH ((bf16*)(args.ws + WS_VH))
#define QI ((bf16*)(args.ws + WS_QI))
#define KIB ((bf16*)(args.ws + WS_KIB))
#define WI ((float*)(args.ws + WS_WI))
#define CXB ((bf16*)(args.ws + WS_CXB))
#define SGA ((bf16*)(args.ws + WS_SGA))
#define SGB ((bf16*)(args.ws + WS_SGB))
#define MASKW ((u64*)(args.ws + WS_MASK))
#define ATT ((bf16*)(args.ws + WS_ATT))
#define CBY ((bf16*)(args.ws + WS_CBY))
#define MX ((bf16*)(args.ws + WS_MX))
#define X2 ((float*)(args.ws + WS_X2))
#define XB ((bf16*)(args.ws + WS_XB))
#define HID ((bf16*)(args.ws + WS_HID))
#define QS ((float*)(args.ws + WS_QS))
#define SSC ((float*)(args.ws + WS_SSC))
#define SEL ((int*)(args.ws + WS_SEL))
#define SSQ1 ((float*)(args.ws + WS_CTL) + CW_SSQ1)
#define SSQ2 ((float*)(args.ws + WS_CTL) + CW_SSQ2)

    for (int u = F.tid; u < (LDS_BYTES - LDSCTL_OFF) / 4; u += NWAVES * 64) ((LAS unsigned*)(F.lds + LDSCTL_OFF))[u] = 0u;
    __syncthreads();
    XcdBarrier bar; bar.bar = (unsigned*)(F.ctl + CW_BAR); bar.x = 0; bar.st = nullptr;
    if (N_LAUNCHES == 1) bar = xcd_barrier_post((unsigned*)(F.ctl + CW_BAR), F.MISC + 8);
#define GRID_BAR() do { if (N_LAUNCHES == 1) xcd_barrier(bar); } while (0)
    constexpr int lo = PH_LO, hi = PH_HI;
#ifndef PHASE_MASK
#define PHASE_MASK 0x3ff
#endif
#define IN(k) (((PHASE_MASK >> (k)) & 1) && lo <= (k) && (k) < hi)
#define BOTH(k) (IN(k) && IN((k) + 1))

    if (IN(0)) { asm volatile("; PHASE_MARK 0" ::: "memory");
        P0Args a{x_prompt, x_sample, norm_mix_g, w_in, w_pa, w_pb, w_o, norm_mlp_g, w_mlp_in, w_mlp_out, WinT, WpaT, WpbT, WoT, W1T, W2T, HBUF};
        p0_prologue(F, a);
        if (BOTH(0)) GRID_BAR();
    }
    if (IN(1)) { asm volatile("; PHASE_MARK 1" ::: "memory");
        pg8::Gemm g{HBUF, WinT, HBUF, WinT, D}; pg8::StaticOrder S; S.init(MPAD, NINP, F.G, (int)blockIdx.x);
        EpiInProj E{out, QH, KH, VH, QI, KIB, CXB, SGA, SGB, WI, QS};
        pg8::gemm_phase<EpiInProj, pg8::StaticOrder, PG8_ALIGN, PG8_SP2>(F.lds + RING_OFF, g, S, E);
        if (BOTH(1)) GRID_BAR();
    }
    if (IN(2)) { asm volatile("; PHASE_MARK 2" ::: "memory");
        for (int L = F.vcu; L < 256; L += F.G) {
            idx_unit(F.lds, QI, KIB, WI, MASKW, L >> 7, L & 127, F.tid, F.wave, F.lane);
            const int L2 = 511 - L;
            idx_unit(F.lds, QI, KIB, WI, MASKW, L2 >> 7, L2 & 127, F.tid, F.wave, F.lane);
        }
        for (int L = F.vcu; L < 256; L += F.G) sidx_unit(QI, KIB, WI, cache_kidx, page_table, SSC, L >> 5, L & 31, F.wave, F.lane);
        ConvArgs ca{CXB, conv_w, state_conv, CBY, out};
        conv_items(F, ca);
        if (BOTH(2)) GRID_BAR();
    }
    if (IN(3)) { asm volatile("; PHASE_MARK 3" ::: "memory");
        typedef att::BlockRef<bf16, bf16> BR;
        auto mkref = [&](int L) { const int bh = L >> 3, qb = L & 7, b = bh >> 3, h = bh & 7; BR r;
            r.Q = QH + ((size_t)bh * T + (size_t)qb * 256) * HD; r.K = KH + (size_t)bh * T * HD; r.V = VH + (size_t)bh * T * HD;
            r.O = ATT + ((size_t)b * T + (size_t)qb * 256) * AW + h * HD; r.P0 = qb * 256; r.MW = MASKW + ((size_t)b * T + (size_t)qb * 256) * 32; return r; };
        auto mkstrip = [&](int L) { const int h = (L >> 3) & 7; const float c31 = rel_bias[31 * NH + h];
            for (int i = F.tid; i < att::STRIP_N; i += NWAVES * 64) { const int dist = i - 256;
                ((LAS float*)(F.lds + att::STRIP_OFF))[i] = (dist >= 0 && dist < 113) ? (rel_bias[rel_bucket(dist) * NH + h] - c31) * (1.0f / att::SCALE) : 0.f; } };
        if (F.vcu < 256) {
            int L = F.vcu; BR cur = mkref(L);
            att::Seam<bf16> S;
            mkstrip(L);
            att::causal_swa_prime<bf16, bf16>(cur, 1 << 30, (char*)lds, S);
            for (;;) {
                const bool last = L + F.G >= 256;
                const BR nxt = last ? cur : mkref(L + F.G);
                att::causal_swa_block<bf16, bf16>(cur, nxt, T, 1 << 30, (char*)lds, F.lds, S);
                if (last) break;
                cur = nxt; L += F.G;
                mkstrip(L); __syncthreads();
            }
        }
        VM_WAIT(); __syncthreads();
        if (F.G == 256) { if ((F.vcu & 7) == 0) ssel_unit(F.lds, SSC, SEL, F.vcu >> 3, F.tid, F.wave, F.lane); }
        else for (int q = F.vcu; q < MS; q += F.G) ssel_unit(F.lds, SSC, SEL, q, F.tid, F.wave, F.lane);
        if (BOTH(3)) GRID_BAR();
    }
    if (IN(4)) { asm volatile("; PHASE_MARK 4" ::: "memory");
        SAttArgs sa{QS, out + OUT_KS, out + OUT_VS, cache_k, cache_v, rel_bias, page_table, SEL, ATT};
        for (int L = F.vcu; L < MS * NH; L += F.G) satt_unit(F.lds, sa, L >> 3, L & 7, F.tid, F.wave, F.lane);
        if (BOTH(4)) GRID_BAR();
    }
    if (IN(5)) { asm volatile("; PHASE_MARK 5" ::: "memory");
        pg8::Gemm g{ATT, WpaT, CBY, WpbT, AW}; pg8::StaticOrder S; S.init(MPAD, D, F.G, (int)blockIdx.x, 2);
        EpiMix E{SGA, SGB, MX};
        pg8::gemm_phase<EpiMix, pg8::StaticOrder, PG8_ALIGN, PG8_SP2>(F.lds + RING_OFF, g, S, E);
        if (BOTH(5)) GRID_BAR();
    }
    if (IN(6)) { asm volatile("; PHASE_MARK 6" ::: "memory");
        pg8::Gemm g{MX, WoT, MX, WoT, D}; pg8::StaticOrder S; S.init(MPAD, D, F.G, (int)blockIdx.x);
        EpiWo E{x_prompt, x_sample, X2, XB, SSQ1};
        pg8::gemm_phase<EpiWo, pg8::StaticOrder, PG8_ALIGN, PG8_SP2>(F.lds + RING_OFF, g, S, E);
        if (BOTH(6)) GRID_BAR();
    }
    if (IN(7)) { asm volatile("; PHASE_MARK 7" ::: "memory");
        pg8::Gemm g{XB, W1T, XB, W1T, D}; pg8::StaticOrder S; S.init(MPAD, FF, F.G, (int)blockIdx.x);
        EpiUp E{SSQ1, HID};
        pg8::gemm_phase<EpiUp, pg8::StaticOrder, PG8_ALIGN, PG8_SP2>(F.lds + RING_OFF, g, S, E);
        if (BOTH(7)) GRID_BAR();
    }
    if (IN(8)) { asm volatile("; PHASE_MARK 8" ::: "memory");
        pg8::Gemm g{HID, W2T, HID, W2T, FF}; pg8::StaticOrder S; S.init(MPAD, D, F.G, (int)blockIdx.x);
        EpiDown E{X2, out, SSQ2};
        pg8::gemm_phase<EpiDown, pg8::StaticOrder, PG8_ALIGN, PG8_SP2>(F.lds + RING_OFF, g, S, E);
        if (BOTH(8)) GRID_BAR();
    }
    if (IN(9)) asm volatile("; PHASE_MARK 9" ::: "memory");
    if (IN(9)) final_norm(F, out, SSQ2, norm_final_g);
#undef IN
#undef BOTH
#undef GRID_BAR
}
#undef x_prompt
#undef x_sample
#undef cache_k
#undef cache_v
#undef cache_kidx
#undef state_conv
#undef page_table
#undef rel_bias
#undef norm_mix_g
#undef w_in
#undef conv_w
#undef w_pa
#undef w_pb
#undef w_o
#undef norm_mlp_g
#undef w_mlp_in
#undef w_mlp_out
#undef norm_final_g
#undef out
#undef WinT
#undef WpaT
#undef WpbT
#undef WoT
#undef W1T
#undef W2T
#undef HBUF
#undef QH
#undef KH
#undef VH
#undef QI
#undef KIB
#undef WI
#undef CXB
#undef SGA
#undef SGB
#undef MASKW
#undef ATT
#undef CBY
#undef MX
#undef X2
#undef XB
#undef HID
#undef QS
#undef SSC
#undef SEL
#undef SSQ1
#undef SSQ2

template <int PH_LO, int PH_HI> static bool launch_range(int grid, const Args& a, hipStream_t stream) {
    static bool attr = false;
    if (!attr) { if (hipFuncSetAttribute((const void*)fwd<PH_LO, PH_HI>, hipFuncAttributeMaxDynamicSharedMemorySize, LDS_BYTES) != hipSuccess) { fprintf(stderr, "kernel_launch: hipFuncSetAttribute failed\n"); return false; } attr = true; }
    hipLaunchKernelGGL((fwd<PH_LO, PH_HI>), dim3(grid), dim3(NWAVES * 64), LDS_BYTES, stream, a);
    const hipError_t le = hipPeekAtLastError();
    if (le != hipSuccess) { fprintf(stderr, "kernel_launch: launch of phases [%d,%d) failed: %s\n", PH_LO, PH_HI, hipGetErrorName(le)); return false; }
    return true;
}
extern "C" void kernel_launch(void* const* d_in, const int* in_sizes, int n_in, void* d_out, int out_size, void* d_ws, size_t ws_size, hipStream_t stream) {
    static int grid = 0;
    if (grid == 0) {
        if (n_in != 18 || ws_size < WS_END) { fprintf(stderr, "kernel_launch: built for 18 inputs and >= %zu bytes of workspace; got n_in %d, ws %zu; nothing launched\n", (size_t)WS_END, n_in, ws_size); grid = -1; return; }
        int dev = 0, cus = 0;
        if (hipGetDevice(&dev) != hipSuccess || hipDeviceGetAttribute(&cus, hipDeviceAttributeMultiprocessorCount, dev) != hipSuccess) { grid = -1; return; }
        grid = cus;
    }
    if (grid < 0) return;
    (void)in_sizes; (void)out_size;
    if (hipMemsetAsync((char*)d_ws + WS_CTL, 0, CTL_ZERO_BYTES, stream) != hipSuccess) { fprintf(stderr, "kernel_launch: hipMemsetAsync failed\n"); return; }
    Args a{};
    for (int i = 0; i < 18; ++i) a.in[i] = d_in[i];
    a.out = (float*)d_out; a.ws = (unsigned char*)d_ws;
    if constexpr (N_LAUNCHES == 1) { launch_range<0, NPH>(grid, a, stream); }
    else {
        if (!launch_range<0, 1>(grid, a, stream)) return;
        if (!launch_range<1, 2>(grid, a, stream)) return;
        if (!launch_range<2, 3>(grid, a, stream)) return;
        if (!launch_range<3, 4>(grid, a, stream)) return;
        if (!launch_range<4, 5>(grid, a, stream)) return;
        if (!launch_range<5, 6>(grid, a, stream)) return;
        if (!launch_range<6, 7>(grid, a, stream)) return;
        if (!launch_range<7, 8>(grid, a, stream)) return;
        if (!launch_range<8, 9>(grid, a, stream)) return;
        launch_range<9, 10>(grid, a, stream);
    }
}
```

```cpp
#include <hip/hip_runtime.h>
#include <cstdio>
#include <cstdint>

#ifndef MK_N_LAUNCHES
#define MK_N_LAUNCHES 1
#endif

constexpr int T = 2048, NB = 4, MPR = NB * T;
constexpr int DB = 8, DT = 4, MS = DB * DT;
constexpr int MTOT = MPR + MS;
constexpr int MPAD = 8448;
constexpr int D = 2048, AW = 1024, CWD = 1024, FF = 8192, NH = 8, HD = 128, IH = 16, IDM = 64;
constexpr int NIN = 11344, NINP = 11520;
constexpr int PAST = 16384, PAGE = 128, NPAGES = 128, TOPK = 256;
constexpr float EPS = 1e-6f;
constexpr int SSTR = 16448;
constexpr int NKS = PAST + DT;
constexpr size_t OUT_Y = 0, OUT_YS = 16777216, OUT_K = 16842752, OUT_V = 25231360, OUT_KI = 33619968, OUT_CONV = 34144256,
                 OUT_KS = 34152448, OUT_VS = 34185216, OUT_KIS = 34217984, OUT_CONVS = 34220032;

#define GAS __attribute__((address_space(1)))
#define LAS __attribute__((address_space(3)))
typedef unsigned short bf16;
typedef unsigned v4u __attribute__((ext_vector_type(4)));
typedef unsigned v2u __attribute__((ext_vector_type(2)));
typedef float f32x4 __attribute__((ext_vector_type(4)));
typedef float f32x2 __attribute__((ext_vector_type(2)));
typedef float f32x16 __attribute__((ext_vector_type(16)));
typedef short bf16x8 __attribute__((ext_vector_type(8)));
typedef short s16x4 __attribute__((ext_vector_type(4)));
typedef GAS unsigned gu32;
typedef GAS unsigned long long gu64;
typedef unsigned long long u64;
#define RLX_AGENT __ATOMIC_RELAXED, __HIP_MEMORY_SCOPE_AGENT
#define LDS_WAIT() asm volatile("s_waitcnt lgkmcnt(0)" ::: "memory")
#define VM_WAIT() asm volatile("s_waitcnt vmcnt(0)" ::: "memory")

typedef __bf16 bf16x2_t __attribute__((ext_vector_type(2)));
__device__ __forceinline__ unsigned cvt_pk_bf16(float lo, float hi) { const f32x2 v = {lo, hi}; const bf16x2_t b = __builtin_convertvector(v, bf16x2_t); return __builtin_bit_cast(unsigned, b); }
__device__ __forceinline__ v4u pack8(f32x4 a, f32x4 b) { v4u w; w.x = cvt_pk_bf16(a[0], a[1]); w.y = cvt_pk_bf16(a[2], a[3]); w.z = cvt_pk_bf16(b[0], b[1]); w.w = cvt_pk_bf16(b[2], b[3]); return w; }
__device__ __forceinline__ float bf_lo(unsigned w) { return __uint_as_float(w << 16); }
__device__ __forceinline__ float bf_hi(unsigned w) { return __uint_as_float(w & 0xffff0000u); }
__device__ __forceinline__ float sigmoidf_(float v) { return __builtin_amdgcn_rcpf(1.0f + __builtin_amdgcn_exp2f(-1.4426950408889634f * v)); }

namespace pg8 {
#define PG8_LAS __attribute__((address_space(3)))
typedef unsigned short bf16_t;
typedef short bf16x8 __attribute__((ext_vector_type(8)));
typedef float f32x4 __attribute__((ext_vector_type(4)));
typedef unsigned u32x4 __attribute__((ext_vector_type(4)));
constexpr int BM = 256, BK = 64, HALF = 128, HTB = HALF * BK * 2  , STAGE_BYTES = 8 * HTB, NXCD = 8, WGM = 8;

__host__ __device__ __forceinline__ int lds_byte(int r, int c) { const int st = (r >> 4) * 2 + (c >> 5), rr = r & 15, cc = c & 31, ob = rr * 64 + cc * 2; return st * 1024 + (ob ^ (((ob >> 9) & 1) << 5)); }
__host__ __device__ __forceinline__ void stage_rc(int b, int& R, int& C) { const int st = b / 1024, sb = b % 1024, swz = sb ^ (((sb >> 9) & 1) << 5); R = (st >> 1) * 16 + swz / 64; C = (st & 1) * 32 + (swz % 64) / 2; }
__host__ __device__ __forceinline__ int perm32(int rho) { const int n = rho >> 4, i = rho & 15; return 8 * (i >> 2) + 4 * n + (i & 3); }

struct Unit { int pm, pn, seg; };
struct Gemm { const bf16_t* A0; const bf16_t* B0; const bf16_t* A1; const bf16_t* B1; int K; };

struct StaticOrder {
    int nM, nN, nwg, G, c, nseg;
    __host__ __device__ void init(int M, int N, int G_, int c_, int nseg_ = 1) { nM = M / BM; nN = N / BM; nwg = nM * nN; G = G_; c = c_; nseg = nseg_; }
    __host__ __device__ bool next(int i, Unit& u) const {
        const int ii = i / nseg; u.seg = i - ii * nseg;
        const long L = (long)ii * G + c; if (L >= nwg) return false;
        int wgid = (int)L; { const int q = nwg / NXCD, r = nwg % NXCD, xcd = wgid % NXCD, off = wgid / NXCD; wgid = (xcd < r ? xcd * (q + 1) : r * (q + 1) + (xcd - r) * q) + off; }
        const int nig = WGM * nN, gid = wgid / nig, fm = gid * WGM, gsz = (nM - fm) < WGM ? (nM - fm) : WGM;
        u.pm = fm + ((wgid % nig) % gsz); u.pn = (wgid % nig) / gsz; return true;
    }
    __device__ __forceinline__ void a_ready(const Unit&) const {}
    __device__ __forceinline__ void done(const Unit&) const {}
};
template <class Epi, class Sched, bool ALIGN_EPI = false, bool SP2 = false>
__device__ __forceinline__ void gemm_phase(PG8_LAS unsigned char* lds, const Gemm g, const Sched& S, const Epi& E, int tid_in) {
    int tid_ = tid_in; asm volatile("" : "+v"(tid_));
    const int tid = tid_, wid = __builtin_amdgcn_readfirstlane(tid >> 6), lane = tid & 63, wr = wid >> 2, wc = wid & 3, fr = lane & 15, fq = lane >> 4;
    const int K = g.K, nt = K / BK;
    unsigned voffA[2], voffB[2];
#pragma unroll
    for (int i = 0; i < 2; ++i) { int R, C; stage_rc(tid * 16 + i * 8192, R, C); const int Rb = Epi::PERM ? ((R & ~31) + perm32(R & 31)) : R;
        voffA[i] = (unsigned)(R * K + C) * 2u; voffB[i] = (unsigned)(Rb * K + C) * 2u; }
    const size_t kstep = (size_t)(BK * 2);
    const size_t hstep = (size_t)HALF * K * 2;
    const size_t tstep = 2 * hstep;
    const unsigned ldsw = (unsigned)wid * 1024u;
    const int aoff = lds_byte(wr * 64 + fr, fq * 8), boff = lds_byte(wc * 32 + fr, fq * 8);
#define PG8_SA(b, h) (((b) * 2 + (h)) * HTB)
#define PG8_SB(b, h) ((4 + (b) * 2 + (h)) * HTB)
#define PG8_STAGE(bufoff, gbase, voff) do { _Pragma("unroll") for (int _i = 0; _i < 2; ++_i) \
        __builtin_amdgcn_global_load_lds((const unsigned*)((const char*)(gbase) + (voff)[_i]), (PG8_LAS unsigned*)(lds + (bufoff) + ldsw + _i * 8192), 16, 0, 0); } while (0)
#define PG8_LDA(dst, b, h) do { _Pragma("unroll") for (int m = 0; m < 4; ++m) _Pragma("unroll") for (int k = 0; k < 2; ++k) dst[m][k] = *(const PG8_LAS bf16x8*)(lds + PG8_SA(b, h) + aoff + m * 2048 + k * 1024); } while (0)
#define PG8_LDB(dst, b, h) do { _Pragma("unroll") for (int n = 0; n < 2; ++n) _Pragma("unroll") for (int k = 0; k < 2; ++k) dst[n][k] = *(const PG8_LAS bf16x8*)(lds + PG8_SB(b, h) + boff + n * 2048 + k * 1024); } while (0)
#define PG8_MMA(ai, bj, At, Bt) do { __builtin_amdgcn_s_setprio(1); _Pragma("unroll") for (int m = 0; m < 4; ++m) _Pragma("unroll") for (int n = 0; n < 2; ++n) _Pragma("unroll") for (int k = 0; k < 2; ++k) \
        acc[ai][bj][m][n] = __builtin_amdgcn_mfma_f32_16x16x32_bf16(Bt[n][k], At[m][k], acc[ai][bj][m][n], 0, 0, 0); __builtin_amdgcn_s_setprio(0); } while (0)
#define PG8_WAIT_V(n) asm volatile("s_waitcnt vmcnt(" #n ")" ::: "memory")
#define PG8_WAIT_L(n) asm volatile("s_waitcnt lgkmcnt(" #n ")" ::: "memory")
#define PG8_BAR __builtin_amdgcn_s_barrier()
#define PG8_SCHED __builtin_amdgcn_sched_barrier(0)
    Unit cur, nxt; int ui = 0;
    if (!S.next(0, cur)) return;
    f32x4 acc[2][2][4][2];
#pragma unroll
    for (int a = 0; a < 2; ++a)
#pragma unroll
        for (int b = 0; b < 2; ++b)
#pragma unroll
            for (int m = 0; m < 4; ++m)
#pragma unroll
                for (int n = 0; n < 2; ++n) acc[a][b][m][n] = (f32x4){0.f, 0.f, 0.f, 0.f};
    bf16x8 At[4][2], B0[2][2], B1[2][2];
    const char* cA = (const char*)(cur.seg ? g.A1 : g.A0) + (size_t)cur.pm * tstep; const char* cB = (const char*)(cur.seg ? g.B1 : g.B0) + (size_t)cur.pn * tstep;
    S.a_ready(cur);
    if constexpr (SP2) {
        PG8_STAGE(PG8_SB(0, 0), cB, voffB); PG8_STAGE(PG8_SB(0, 1), cB + hstep, voffB); PG8_STAGE(PG8_SA(0, 0), cA, voffA); PG8_STAGE(PG8_SA(0, 1), cA + hstep, voffA);
        if (wr == 1) PG8_BAR;
        PG8_WAIT_V(2); PG8_BAR;
        PG8_STAGE(PG8_SB(1, 0), cB + kstep, voffB); PG8_STAGE(PG8_SA(1, 0), cA + kstep, voffA); PG8_STAGE(PG8_SB(1, 1), cB + hstep + kstep, voffB);
        PG8_WAIT_V(6); PG8_BAR;
    } else {
        PG8_STAGE(PG8_SB(0, 0), cB, voffB); PG8_STAGE(PG8_SA(0, 0), cA, voffA); PG8_STAGE(PG8_SB(0, 1), cB + hstep, voffB); PG8_STAGE(PG8_SA(0, 1), cA + hstep, voffA);
        if (wr == 1) PG8_BAR;
        PG8_WAIT_V(4); PG8_BAR;
        PG8_STAGE(PG8_SB(1, 0), cB + kstep, voffB); PG8_STAGE(PG8_SA(1, 0), cA + kstep, voffA); PG8_STAGE(PG8_SB(1, 1), cB + hstep + kstep, voffB);
        PG8_WAIT_V(6); PG8_BAR;
    }
    for (;;) {
        const bool has_next = S.next(ui + 1, nxt);
        const char* nA = has_next ? (const char*)(nxt.seg ? g.A1 : g.A0) + (size_t)nxt.pm * tstep : cA; const char* nB = has_next ? (const char*)(nxt.seg ? g.B1 : g.B0) + (size_t)nxt.pn * tstep : cB;
        for (int t = 0; t < nt; t += 2) {
            const bool last = (t == nt - 2);
            const char* a1 = cA + (size_t)(t + 1) * kstep;
            const char* a2 = last ? nA : cA + (size_t)(t + 2) * kstep; const char* b2 = last ? nB : cB + (size_t)(t + 2) * kstep;
            const char* a3 = a2 + kstep; const char* b3 = b2 + kstep;
            if (last && has_next) S.a_ready(nxt);
            if constexpr (SP2) {
            PG8_LDB(B0, 0, 0); PG8_LDB(B1, 0, 1); PG8_SCHED; PG8_LDA(At, 0, 0); PG8_STAGE(PG8_SA(1, 1), a1 + hstep, voffA);
            PG8_WAIT_V(8); PG8_WAIT_L(0); PG8_BAR; PG8_MMA(0, 0, At, B0); PG8_MMA(0, 1, At, B1); PG8_BAR; PG8_SCHED;
            PG8_LDA(At, 0, 1); PG8_STAGE(PG8_SB(0, 0), b2, voffB); PG8_STAGE(PG8_SB(0, 1), b2 + hstep, voffB); PG8_STAGE(PG8_SA(0, 0), a2, voffA);
            PG8_WAIT_V(8); PG8_WAIT_L(0); PG8_BAR; PG8_MMA(1, 0, At, B0); PG8_MMA(1, 1, At, B1); PG8_BAR; PG8_SCHED;
            PG8_LDB(B0, 1, 0); PG8_LDB(B1, 1, 1); PG8_SCHED; PG8_LDA(At, 1, 0); PG8_STAGE(PG8_SA(0, 1), a2 + hstep, voffA);
            PG8_WAIT_V(8); PG8_WAIT_L(0); PG8_BAR; PG8_MMA(0, 0, At, B0); PG8_MMA(0, 1, At, B1); PG8_BAR; PG8_SCHED;
            PG8_LDA(At, 1, 1); PG8_STAGE(PG8_SB(1, 0), b3, voffB); PG8_STAGE(PG8_SB(1, 1), b3 + hstep, voffB); PG8_STAGE(PG8_SA(1, 0), a3, voffA);
            PG8_WAIT_V(8); PG8_WAIT_L(0); PG8_BAR; PG8_MMA(1, 0, At, B0); PG8_MMA(1, 1, At, B1); PG8_BAR; PG8_SCHED;
            } else {
            PG8_LDB(B0, 0, 0); PG8_SCHED; PG8_LDA(At, 0, 0); PG8_STAGE(PG8_SA(1, 1), a1 + hstep, voffA);
            PG8_WAIT_L(8); PG8_BAR; PG8_WAIT_L(0); PG8_MMA(0, 0, At, B0); PG8_BAR; PG8_SCHED;
            PG8_LDB(B1, 0, 1); PG8_STAGE(PG8_SB(0, 0), b2, voffB);
            PG8_BAR; PG8_WAIT_L(0); PG8_MMA(0, 1, At, B1); PG8_BAR;
            PG8_LDA(At, 0, 1); PG8_STAGE(PG8_SA(0, 0), a2, voffA);
            PG8_BAR; PG8_WAIT_L(0); PG8_MMA(1, 0, At, B0); PG8_BAR; PG8_SCHED;
            PG8_STAGE(PG8_SB(0, 1), b2 + hstep, voffB);
            PG8_WAIT_V(6); PG8_BAR; PG8_MMA(1, 1, At, B1); PG8_BAR;
            PG8_LDB(B0, 1, 0); PG8_SCHED; PG8_LDA(At, 1, 0); PG8_STAGE(PG8_SA(0, 1), a2 + hstep, voffA);
            PG8_WAIT_L(8); PG8_BAR; PG8_WAIT_L(0); PG8_MMA(0, 0, At, B0); PG8_BAR; PG8_SCHED;
            PG8_LDB(B1, 1, 1); PG8_STAGE(PG8_SB(1, 0), b3, voffB);
            PG8_BAR; PG8_WAIT_L(0); PG8_MMA(0, 1, At, B1); PG8_BAR;
            PG8_LDA(At, 1, 1); PG8_STAGE(PG8_SA(1, 0), a3, voffA);
            PG8_BAR; PG8_WAIT_L(0); PG8_MMA(1, 0, At, B0); PG8_BAR; PG8_SCHED;
            PG8_STAGE(PG8_SB(1, 1), b3 + hstep, voffB);
            PG8_WAIT_V(6); PG8_BAR; PG8_MMA(1, 1, At, B1); PG8_BAR;
            }
        }
        if constexpr (ALIGN_EPI) { if (wr == 0) PG8_BAR; }
        if constexpr (!Epi::AFTER_DRAIN) { E(acc, cur, wr, wc, fr, fq); S.done(cur); }
        if (!has_next) break;
        if (Epi::NSEG == 1 || cur.seg == Epi::NSEG - 1) {
#pragma unroll
        for (int a = 0; a < 2; ++a)
#pragma unroll
            for (int b = 0; b < 2; ++b)
#pragma unroll
                for (int m = 0; m < 4; ++m)
#pragma unroll
                    for (int n = 0; n < 2; ++n) acc[a][b][m][n] = (f32x4){0.f, 0.f, 0.f, 0.f};
        }
        cur = nxt; cA = nA; cB = nB; ++ui;
        if constexpr (ALIGN_EPI) { if (wr == 1) PG8_BAR; }
    }
    PG8_WAIT_V(0);
    if constexpr (!ALIGN_EPI) { if (wr == 0) PG8_BAR; }
    PG8_BAR;
    if constexpr (Epi::AFTER_DRAIN) { E.fused(acc, cur, wr, wc, fr, fq, lds, wid, lane); S.done(cur); }
#undef PG8_SA
#undef PG8_SB
#undef PG8_STAGE
#undef PG8_LDA
#undef PG8_LDB
#undef PG8_MMA
#undef PG8_WAIT_V
#undef PG8_WAIT_L
#undef PG8_BAR
#undef PG8_SCHED
}
}
#define PG8_SP2 true
#define PG8_ALIGN true

using pg8::Unit;
#define EPI_ROWS(...) _Pragma("unroll") for (int ai = 0; ai < 2; ++ai) _Pragma("unroll") for (int m = 0; m < 4; ++m) { const int rl = 128 * ai + 64 * wr + 16 * m + fr; const int row = u.pm * 256 + rl; (void)row; \
    _Pragma("unroll") for (int bj = 0; bj < 2; ++bj) { const int c8 = 128 * bj + 32 * wc + 8 * fq; f32x4 v0 = acc[ai][bj][m][0], v1 = acc[ai][bj][m][1]; (void)c8; __VA_ARGS__ } }

struct EpiInProj {
    static constexpr bool PERM = true, AFTER_DRAIN = false; static constexpr int NSEG = 1;
    float* out; bf16 *QH, *KH, *VH, *QI, *KIB, *CXB, *SGA, *SGB; float *WI, *QS;
    __device__ __forceinline__ void operator()(f32x4 (&acc)[2][2][4][2], const Unit& u, int wr, int wc, int fr, int fq) const {
        const int pn = u.pn; const bool samp = (u.pm == 32);
        if (pn < 12) {
            const int which = pn >> 2, cb0 = (pn & 3) * 256;
            bf16* HB = QH + (size_t)which * ((size_t)MPR * AW);
            float* op = out + (which == 1 ? OUT_K : OUT_V); float* qs_or_out = out + (which == 1 ? OUT_KS : OUT_VS); if (which == 0) qs_or_out = QS;
            EPI_ROWS({
                const int col = cb0 + c8;
                if (!samp) {
                    const int b = row >> 11, t = row & 2047, h = col >> 7, d = col & 127;
                    *(v4u*)(HB + ((size_t)((b * NH + h) * T + t)) * HD + d) = pack8(v0, v1);
                    if (which) { float* o = op + (size_t)row * AW + col; *(f32x4*)o = v0; *(f32x4*)(o + 4) = v1; }
                } else if (rl < MS) {
                    float* o = qs_or_out + (size_t)rl * AW + col; *(f32x4*)o = v0; *(f32x4*)(o + 4) = v1;
                }
            })
        } else if (pn < 16) {
            const int cb0 = (pn - 12) * 256;
            EPI_ROWS({ if (!samp || rl < MS) *(v4u*)(QI + (size_t)row * 1024 + cb0 + c8) = pack8(v0, v1); })
        } else if (pn == 16) {
            EPI_ROWS({
                if (bj == 0 && (!samp || rl < MS)) {
                    if (wc < 2) { float* o = samp ? out + OUT_KIS + (size_t)rl * IDM + c8 : out + OUT_KI + (size_t)row * IDM + c8; *(f32x4*)o = v0; *(f32x4*)(o + 4) = v1;
                                  *(v4u*)(KIB + (size_t)row * IDM + c8) = pack8(v0, v1); }
                    else if (wc == 2 && fq < 2) { float* o = WI + (size_t)row * IH + 8 * fq; *(f32x4*)o = v0 * 0.03125f; *(f32x4*)(o + 4) = v1 * 0.03125f; }
                }
            })
        } else if (pn < 29) {
            const int sg = (pn - 17) >> 2, cb0 = ((pn - 17) & 3) * 256;
            bf16* P = CXB + (size_t)sg * MPAD * CWD;
            EPI_ROWS({ if (!samp || rl < MS) *(v4u*)(P + (size_t)row * CWD + cb0 + c8) = pack8(v0, v1); })
        } else {
            const bool isb = pn >= 37; const int cb0 = (pn - (isb ? 37 : 29)) * 256; bf16* P = isb ? SGB : SGA;
            EPI_ROWS({ if (!samp || rl < MS) {
                const f32x4 s0 = {sigmoidf_(v0[0]), sigmoidf_(v0[1]), sigmoidf_(v0[2]), sigmoidf_(v0[3])}, s1 = {sigmoidf_(v1[0]), sigmoidf_(v1[1]), sigmoidf_(v1[2]), sigmoidf_(v1[3])};
                *(v4u*)(P + (size_t)row * D + cb0 + c8) = pack8(s0, s1); } })
        }
    }
};

struct EpiMix {
    static constexpr bool PERM = true, AFTER_DRAIN = false; static constexpr int NSEG = 2;
    const bf16 *SGA, *SGB; bf16* MX;
    __device__ __forceinline__ void operator()(f32x4 (&acc)[2][2][4][2], const Unit& u, int wr, int wc, int fr, int fq) const {
        const int cb0 = u.pn * 256;
        if (u.seg == 0) {
            EPI_ROWS({
                const v4u a = *(const v4u*)(SGA + (size_t)row * D + cb0 + c8), b = *(const v4u*)(SGB + (size_t)row * D + cb0 + c8);
                f32x4 r0, r1;
                r0[0] = bf_lo(a.x) * __builtin_amdgcn_rcpf(bf_lo(b.x)); r0[1] = bf_hi(a.x) * __builtin_amdgcn_rcpf(bf_hi(b.x)); r0[2] = bf_lo(a.y) * __builtin_amdgcn_rcpf(bf_lo(b.y)); r0[3] = bf_hi(a.y) * __builtin_amdgcn_rcpf(bf_hi(b.y));
                r1[0] = bf_lo(a.z) * __builtin_amdgcn_rcpf(bf_lo(b.z)); r1[1] = bf_hi(a.z) * __builtin_amdgcn_rcpf(bf_hi(b.z)); r1[2] = bf_lo(a.w) * __builtin_amdgcn_rcpf(bf_lo(b.w)); r1[3] = bf_hi(a.w) * __builtin_amdgcn_rcpf(bf_hi(b.w));
                acc[ai][bj][m][0] = v0 * r0; acc[ai][bj][m][1] = v1 * r1;
            })
        } else {
            EPI_ROWS({
                const v4u b = *(const v4u*)(SGB + (size_t)row * D + cb0 + c8);
                const f32x4 g0 = {bf_lo(b.x), bf_hi(b.x), bf_lo(b.y), bf_hi(b.y)}, g1 = {bf_lo(b.z), bf_hi(b.z), bf_lo(b.w), bf_hi(b.w)};
                *(v4u*)(MX + (size_t)row * D + cb0 + c8) = pack8(v0 * g0, v1 * g1);
            })
        }
    }
};

__device__ __forceinline__ void ssq_add(float* ssq, int row, float s, int fq) {
    s += __shfl_xor(s, 16); s += __shfl_xor(s, 32);
    if (fq == 0) atomicAdd(ssq + row, s);
}

struct EpiWo {
    static constexpr bool PERM = true, AFTER_DRAIN = false; static constexpr int NSEG = 1;
    const float *xp, *xs; float* X2; bf16* XB; float* SSQ;
    __device__ __forceinline__ void operator()(f32x4 (&acc)[2][2][4][2], const Unit& u, int wr, int wc, int fr, int fq) const {
        const int cb0 = u.pn * 256; const bool samp = (u.pm == 32);
#pragma unroll
        for (int ai = 0; ai < 2; ++ai)
#pragma unroll
            for (int m = 0; m < 4; ++m) { const int rl = 128 * ai + 64 * wr + 16 * m + fr; const int row = u.pm * 256 + rl; float s = 0.f;
                const bool valid = !samp || rl < MS; const float* xr = samp ? xs + (size_t)(rl & (MS - 1)) * D : xp + (size_t)row * D;
#pragma unroll
                for (int bj = 0; bj < 2; ++bj) { const int c = cb0 + 128 * bj + 32 * wc + 8 * fq;
                    f32x4 a0 = *(const f32x4*)(xr + c), a1 = *(const f32x4*)(xr + c + 4);
                    if (!valid) { a0 = (f32x4){0.f, 0.f, 0.f, 0.f}; a1 = a0; }
                    const f32x4 v0 = acc[ai][bj][m][0] + a0, v1 = acc[ai][bj][m][1] + a1;
                    *(f32x4*)(X2 + (size_t)row * D + c) = v0; *(f32x4*)(X2 + (size_t)row * D + c + 4) = v1;
                    *(v4u*)(XB + (size_t)row * D + c) = pack8(v0, v1);
                    s += (v0[0] * v0[0] + v0[1] * v0[1]) + (v0[2] * v0[2] + v0[3] * v0[3]) + (v1[0] * v1[0] + v1[1] * v1[1]) + (v1[2] * v1[2] + v1[3] * v1[3]); }
                ssq_add(SSQ, row, s, fq); }
    }
};

struct EpiUp {
    static constexpr bool PERM = true, AFTER_DRAIN = false; static constexpr int NSEG = 1;
    const float* SSQ; bf16* HID;
    __device__ __forceinline__ void operator()(f32x4 (&acc)[2][2][4][2], const Unit& u, int wr, int wc, int fr, int fq) const {
        const int cb0 = u.pn * 256;
#pragma unroll
        for (int ai = 0; ai < 2; ++ai)
#pragma unroll
            for (int m = 0; m < 4; ++m) { const int rl = 128 * ai + 64 * wr + 16 * m + fr; const int row = u.pm * 256 + rl;
                const float rs = __builtin_amdgcn_rsqf(__hip_atomic_load(SSQ + row, RLX_AGENT) * (1.0f / D) + EPS);
#pragma unroll
                for (int bj = 0; bj < 2; ++bj) { const int c = cb0 + 128 * bj + 32 * wc + 8 * fq;
                    f32x4 v0 = acc[ai][bj][m][0] * rs, v1 = acc[ai][bj][m][1] * rs;
#pragma unroll
                    for (int j = 0; j < 4; ++j) { const float a = fmaxf(v0[j], 0.f), b = fmaxf(v1[j], 0.f); v0[j] = a * a; v1[j] = b * b; }
                    *(v4u*)(HID + (size_t)row * FF + c) = pack8(v0, v1); } }
    }
};

struct EpiDown {
    static constexpr bool PERM = true, AFTER_DRAIN = false; static constexpr int NSEG = 1;
    const float* X2; float* out; float* SSQ;
    __device__ __forceinline__ void operator()(f32x4 (&acc)[2][2][4][2], const Unit& u, int wr, int wc, int fr, int fq) const {
        const int cb0 = u.pn * 256; const bool samp = (u.pm == 32);
#pragma unroll
        for (int ai = 0; ai < 2; ++ai)
#pragma unroll
            for (int m = 0; m < 4; ++m) { const int rl = 128 * ai + 64 * wr + 16 * m + fr; const int row = u.pm * 256 + rl; float s = 0.f;
                const bool valid = !samp || rl < MS; float* orow = samp ? out + OUT_YS + (size_t)(rl & (MS - 1)) * D : out + OUT_Y + (size_t)row * D;
#pragma unroll
                for (int bj = 0; bj < 2; ++bj) { const int c = cb0 + 128 * bj + 32 * wc + 8 * fq;
                    const f32x4 v0 = acc[ai][bj][m][0] + *(const f32x4*)(X2 + (size_t)row * D + c), v1 = acc[ai][bj][m][1] + *(const f32x4*)(X2 + (size_t)row * D + c + 4);
                    if (valid) { *(f32x4*)(orow + c) = v0; *(f32x4*)(orow + c + 4) = v1; }
                    s += (v0[0] * v0[0] + v0[1] * v0[1]) + (v0[2] * v0[2] + v0[3] * v0[3]) + (v1[0] * v1[0] + v1[1] * v1[1]) + (v1[2] * v1[2] + v1[3] * v1[3]); }
                ssq_add(SSQ, row, s, fq); }
    }
};
#define XB_TMO      128
#define XB_XCNT(j)  (256  + 64 * (j))
#define XB_XSUB(j)  (1280 + 64 * (j))
#define XB_XGEN(j)  (2304 + 64 * (j))
#define XB_TOP      3328
#define XB_TOPGEN   3392
#define XCD_BAR_WORDS 3456
#define XB_SPIN_CAP (1u << 18)

__device__ __forceinline__ unsigned xb_ld(unsigned* p)              { return __hip_atomic_load(p, __ATOMIC_RELAXED, __HIP_MEMORY_SCOPE_AGENT); }
__device__ __forceinline__ unsigned xb_add(unsigned* p, unsigned v) { return __hip_atomic_fetch_add(p, v, __ATOMIC_RELAXED, __HIP_MEMORY_SCOPE_AGENT); }
__device__ __forceinline__ unsigned xb_xcc_id() { return (unsigned)__builtin_amdgcn_s_getreg((3 << 11) | 20) & 0xFu; }
#define XB_SPIN(cond, bar) do { unsigned _sp = 0; while (cond) { __builtin_amdgcn_s_sleep(1); \
    if ((++_sp & 255u) == 0u) { if (xb_ld(&(bar)[XB_TMO])) break; if (_sp > XB_SPIN_CAP) { atomicAdd(&(bar)[XB_TMO], 1u); break; } } } } while (0)

struct XcdBarrier {
    unsigned* bar; unsigned x;
    volatile LAS unsigned* st;
    int w0;
};

__device__ __forceinline__ XcdBarrier xcd_barrier_post(unsigned* bar, volatile LAS unsigned* st) {
    XcdBarrier b; b.bar = bar; b.x = xb_xcc_id(); b.st = st; b.w0 = __builtin_amdgcn_readfirstlane(threadIdx.x >> 6);
    if (threadIdx.x == 0) (void)xb_add(&bar[XB_XCNT(b.x)], 1u);
    return b;
}
__device__ __forceinline__ void xcd_barrier_complete(unsigned* bar, unsigned x, unsigned& nloc, unsigned& nx) {
    const unsigned G = gridDim.x * gridDim.y * gridDim.z;
    unsigned sum, cnt, mine, sp = 0u;
    for (;;) {
        sum = 0u; cnt = 0u; mine = 0u;
#pragma unroll
        for (unsigned j = 0; j < 16; ++j) { const unsigned c = xb_ld(&bar[XB_XCNT(j)]); sum += c; cnt += (c > 0u) ? 1u : 0u; mine = (j == x) ? c : mine; }
        if (sum == G) break;
        __builtin_amdgcn_s_sleep(1);
        if ((++sp & 255u) == 0u) { if (xb_ld(&bar[XB_TMO])) break; if (sp > XB_SPIN_CAP) { atomicAdd(&bar[XB_TMO], 1u); break; } }
    }
    nloc = mine > 0u ? mine : 1u; nx = cnt > 0u ? cnt : 1u;
}

__device__ __forceinline__ void xcd_barrier(const XcdBarrier& b) {
    asm volatile("s_waitcnt vmcnt(0)" ::: "memory");
    __syncthreads();
    if (b.w0 == 0 && __builtin_amdgcn_mbcnt_hi(~0u, __builtin_amdgcn_mbcnt_lo(~0u, 0u)) == 0u) {
        unsigned* bar = b.bar;
        __builtin_amdgcn_s_waitcnt(0);
        unsigned nloc = b.st[0], nx = b.st[1];
        if (nloc == 0u) { xcd_barrier_complete(bar, b.x, nloc, nx); b.st[0] = nloc; b.st[1] = nx; }
        const unsigned old = xb_add(&bar[XB_XSUB(b.x)], 1u);
        const unsigned gen = old / nloc;
        if (old + 1u == (gen + 1u) * nloc) {
            __builtin_amdgcn_fence(__ATOMIC_RELEASE, "agent");
            asm volatile("s_waitcnt vmcnt(0)" ::: "memory");
            const unsigned og = xb_add(&bar[XB_TOP], 1u);
            const unsigned tg = og / nx;
            if (og + 1u == (tg + 1u) * nx) xb_add(&bar[XB_TOPGEN], 1u);
            else XB_SPIN(xb_ld(&bar[XB_TOPGEN]) == tg, bar);
            __builtin_amdgcn_fence(__ATOMIC_ACQUIRE, "agent");
            xb_add(&bar[XB_XGEN(b.x)], 1u);
            asm volatile("s_waitcnt vmcnt(0)" ::: "memory");
        } else {
            XB_SPIN(xb_ld(&bar[XB_XGEN(b.x)]) == gen, bar);
            __builtin_amdgcn_fence(__ATOMIC_ACQUIRE, "agent");
            asm volatile("s_waitcnt vmcnt(0)" ::: "memory");
        }
    }
    __syncthreads();
}
namespace att {
constexpr int D = 128;
constexpr float THR = 8.f;
constexpr bool WSKIP = false;
constexpr int OSTR = 1024;
constexpr int STRIP_OFF = 69632, STRIP_N = 2368;
typedef unsigned short bf16;
constexpr float SCALE = 0.08838834764831845f;
constexpr int NW = 8, QBLK = 32, KVBLK = 64, QB = NW * QBLK;
constexpr int SHM_V = KVBLK * D * 2, SHM_K = KVBLK * D * 2;
constexpr int LDS_BYTES = 2 * SHM_V + 2 * SHM_K + NW * 64 * 4;

typedef short bf16x8 __attribute__((ext_vector_type(8)));
typedef short s16x4 __attribute__((ext_vector_type(4)));
typedef float f32x16 __attribute__((ext_vector_type(16)));
typedef float f32x4 __attribute__((ext_vector_type(4)));
typedef unsigned u32x4 __attribute__((ext_vector_type(4)));
template <class A, class Bt> struct same_t { static constexpr bool v = false; };
template <class A> struct same_t<A, A> { static constexpr bool v = true; };

#define KSWZ(row, colB) ((row) * 256 + ((colB) ^ (((row) & 7) << 4)))
#define SBAR() __builtin_amdgcn_sched_barrier(0)
__device__ __forceinline__ int v_st(int k, int c) { const int kk = (k & ~0xC) | ((k & 4) << 1) | ((k & 8) >> 1); return ((kk >> 3) * 4 + (c >> 5)) * 512 + ((kk & 7) * 32 + (c & 31)) * 2; }
__device__ __forceinline__ int v_rd_base(int lane) { return ((lane & 3) << 3) | (((lane >> 2) & 3) << 6) | (((lane >> 4) & 1) << 5) | (((lane >> 5) & 1) << 8); }
constexpr int v_rd_off(int d0, int ks, int half) { return d0 * 512 + ks * 4096 + half * 2048; }
__device__ __forceinline__ int crow(int r, int hi) { return (r & 3) + 8 * (r >> 2) + 4 * hi; }
__device__ __forceinline__ unsigned cvtpk(float lo, float hi) {
    unsigned r; asm volatile("v_cvt_pk_bf16_f32 %0, %1, %2" : "=v"(r) : "v"(lo), "v"(hi)); return r;
}
__device__ __forceinline__ bf16x8 pack8(f32x4 a, f32x4 b) {
    u32x4 w = {cvtpk(a[0], a[1]), cvtpk(a[2], a[3]), cvtpk(b[0], b[1]), cvtpk(b[2], b[3])};
    return *reinterpret_cast<bf16x8*>(&w);
}
template <class T> __device__ __forceinline__ bf16x8 load8(const T* p) {
    if constexpr (same_t<T, float>::v) { return pack8(*(const f32x4*)p, *(const f32x4*)(p + 4)); }
    else { return *reinterpret_cast<const bf16x8*>(p); }
}
__device__ __forceinline__ void mask_tile(f32x16& p0, f32x16& p1, int dq, unsigned W) {
    const float NEG = -__builtin_inff();
#pragma unroll
    for (int r = 0; r < 16; ++r) {
        const int c = (r & 3) + 8 * (r >> 2);
        if ((unsigned)(dq - c) >= W) p0[r] = NEG;
        if ((unsigned)(dq - c - 32) >= W) p1[r] = NEG;
    }
}
__device__ __forceinline__ void mask_bias_tile(f32x16& p0, f32x16& p1, unsigned long long w, const __attribute__((address_space(3))) float* sp, int hi) {
    const float NEG = -__builtin_inff();
    const unsigned wl = (unsigned)w >> (4 * hi), wh = (unsigned)(w >> 32) >> (4 * hi);
#pragma unroll
    for (int r = 0; r < 16; ++r) { const int c = (r & 3) + 8 * (r >> 2);
        p0[r] = ((wl >> c) & 1u) ? p0[r] + sp[59 - c] : NEG;
        p1[r] = ((wh >> c) & 1u) ? p1[r] + sp[27 - c] : NEG; }
}
__device__ __forceinline__ void partialSM(f32x16& p0, f32x16& p1, float& m_reg, float& mn, float& alpha) {
    float pmax = p0[0]; for (int r = 1; r < 16; ++r) pmax = fmaxf(pmax, p0[r]); for (int r = 0; r < 16; ++r) pmax = fmaxf(pmax, p1[r]);
    { auto rr = __builtin_amdgcn_permlane32_swap(__float_as_uint(pmax), __float_as_uint(pmax), false, false);
      pmax = fmaxf(__uint_as_float(rr[0]), __uint_as_float(rr[1])); }
    constexpr float C2 = 1.4426950408889634f * SCALE;
    if (__builtin_expect(__all((pmax - m_reg) * SCALE <= THR), 1)) { mn = m_reg; alpha = 1.f; }
    else { mn = fmaxf(m_reg, pmax); alpha = __builtin_amdgcn_exp2f((m_reg - mn) * C2); m_reg = mn; }
    const float mnL = -mn * C2;
    for (int r = 0; r < 16; ++r) p0[r] = fmaf(p0[r], C2, mnL); for (int r = 0; r < 16; ++r) p1[r] = fmaf(p1[r], C2, mnL);
    for (int r = 0; r < 16; ++r) p0[r] = __builtin_amdgcn_exp2f(p0[r]);
}
__device__ __forceinline__ void finishSM(f32x16& p0, f32x16& p1, float alpha, float& l_reg, bf16x8& pa0, bf16x8& pa1, bf16x8& pa2, bf16x8& pa3) {
    for (int r = 0; r < 16; ++r) p1[r] = __builtin_amdgcn_exp2f(p1[r]);
    float ps = 0; for (int r = 0; r < 16; ++r) ps += p0[r]; for (int r = 0; r < 16; ++r) ps += p1[r];
    { auto rr = __builtin_amdgcn_permlane32_swap(__float_as_uint(ps), __float_as_uint(ps), false, false);
      ps = __uint_as_float(rr[0]) + __uint_as_float(rr[1]); }
    l_reg = l_reg * alpha + ps;
#define PK4(P, B_, OUT) do { unsigned a0 = cvtpk(P[B_+0], P[B_+1]), a1 = cvtpk(P[B_+2], P[B_+3]);                          \
        unsigned b0 = cvtpk(P[B_+4], P[B_+5]), b1 = cvtpk(P[B_+6], P[B_+7]);                                             \
        auto r0 = __builtin_amdgcn_permlane32_swap(a0, b0, false, false); auto r1 = __builtin_amdgcn_permlane32_swap(a1, b1, false, false); \
        u32x4 w = {r0[0], r1[0], r0[1], r1[1]}; OUT = *reinterpret_cast<bf16x8*>(&w); } while (0)
    PK4(p0, 0, pa0); PK4(p0, 8, pa1); PK4(p1, 0, pa2); PK4(p1, 8, pa3);
#undef PK4
}
template <int KB, bool SK>
__device__ __forceinline__ void qkt(f32x16& p0, f32x16& p1, const char* K_lds, int r32, int hi, const bf16x8* qr, bool act) {
    if (SK && !act) { const float NEG = -__builtin_inff();
#pragma unroll
        for (int r = 0; r < 16; ++r) { p0[r] = NEG; p1[r] = NEG; } return; }
    p0 = f32x16{}; p1 = f32x16{};
    const char* kb[4];
#pragma unroll
    for (int dd = 0; dd < 4; ++dd) kb[dd] = K_lds + KB * SHM_K + KSWZ(r32, (dd * 16 + hi * 8) * 2);
#pragma unroll
    for (int d0 = 0; d0 < 8; ++d0) { const char* a = kb[d0 & 3] + (d0 >> 2) * 128;
        bf16x8 b0 = *reinterpret_cast<const bf16x8*>(a);
        bf16x8 b1 = *reinterpret_cast<const bf16x8*>(a + 32 * 256);
        p0 = __builtin_amdgcn_mfma_f32_32x32x16_bf16(b0, qr[d0], p0, 0, 0, 0);
        p1 = __builtin_amdgcn_mfma_f32_32x32x16_bf16(b1, qr[d0], p1, 0, 0, 0); }
}
template <int VB, bool SK>
__device__ __forceinline__ void pv_tile(f32x16* o, int vb0, bf16x8 pa0, bf16x8 pa1, bf16x8 pa2, bf16x8 pa3, bool act) {
    if (SK && !act) return;
#define TRRD(dst, off) asm volatile("ds_read_b64_tr_b16 %0, %1 offset:%2" : "=&v"(dst) : "v"(vb0), "i"(off) : "memory")
#define PV_D0(d0) do { s16x4 l0, l1, l2, l3, h0, h1, h2, h3; constexpr int b_ = VB * SHM_V + v_rd_off(d0, 0, 0);     \
        TRRD(l0, b_); TRRD(h0, b_ + 2048); TRRD(l1, b_ + 4096); TRRD(h1, b_ + 6144); TRRD(l2, b_ + 8192); TRRD(h2, b_ + 10240); TRRD(l3, b_ + 12288); TRRD(h3, b_ + 14336); \
        asm volatile("s_waitcnt lgkmcnt(0)" ::: "memory"); SBAR();                 \
        o[d0] = __builtin_amdgcn_mfma_f32_32x32x16_bf16(pa0, (bf16x8){l0[0], l0[1], l0[2], l0[3], h0[0], h0[1], h0[2], h0[3]}, o[d0], 0, 0, 0);   \
        o[d0] = __builtin_amdgcn_mfma_f32_32x32x16_bf16(pa1, (bf16x8){l1[0], l1[1], l1[2], l1[3], h1[0], h1[1], h1[2], h1[3]}, o[d0], 0, 0, 0);   \
        o[d0] = __builtin_amdgcn_mfma_f32_32x32x16_bf16(pa2, (bf16x8){l2[0], l2[1], l2[2], l2[3], h2[0], h2[1], h2[2], h2[3]}, o[d0], 0, 0, 0);   \
        o[d0] = __builtin_amdgcn_mfma_f32_32x32x16_bf16(pa3, (bf16x8){l3[0], l3[1], l3[2], l3[3], h3[0], h3[1], h3[2], h3[3]}, o[d0], 0, 0, 0); } while (0)
    PV_D0(0); PV_D0(1); PV_D0(2); PV_D0(3);
#undef PV_D0
#undef TRRD
}

template <class TIn, class TOut> struct BlockRef { const TIn* Q; const TIn* K; const TIn* V; TOut* O; int P0; const unsigned long long* MW; };
template <class TIn> struct Seam {
    bf16x8 qr[8];
    bf16x8 st_v0, st_v1, st_k0, st_k1; f32x4 sf0, sf1, sf2, sf3;
    f32x4 tq[16];
};
__device__ __forceinline__ int swa_jlo(int P0, int W) { const int lowk = P0 - W + 1; return lowk > 0 ? lowk / KVBLK : 0; }
#define ROW(p, k0, rr) ((p) + (size_t)((k0) + (rr)) * D + sc)
#define VMW() asm volatile("s_waitcnt vmcnt(0)" ::: "memory")
#define VMWN(n) asm volatile("s_waitcnt vmcnt(%0)" :: "i"(n) : "memory")
#define SLOAD_H(Kp, Vp, k0) do { S.st_v0 = load8<TIn>(ROW(Vp, k0, sr)); S.st_v1 = load8<TIn>(ROW(Vp, k0, 32 + sr));              \
                         S.st_k0 = load8<TIn>(ROW(Kp, k0, sr)); S.st_k1 = load8<TIn>(ROW(Kp, k0, 32 + sr)); } while (0)
#define SWRITE_HK(bf) do { *(bf16x8*)(K_lds + (bf) * SHM_K + kws) = S.st_k0; *(bf16x8*)(K_lds + (bf) * SHM_K + kws + 32 * 256) = S.st_k1; } while (0)
#define SWRITE_HV(bf) do { *(bf16x8*)(V_lds + (bf) * SHM_V + vst0) = S.st_v0; *(bf16x8*)(V_lds + (bf) * SHM_V + vst1) = S.st_v1; } while (0)
#define SWRITE_H(bf) do { SWRITE_HV(bf); SWRITE_HK(bf); } while (0)
#define SLOAD_F(p, k0) do { S.sf0 = *(const f32x4*)ROW(p, k0, sr); S.sf1 = *(const f32x4*)(ROW(p, k0, sr) + 4);                \
                            S.sf2 = *(const f32x4*)ROW(p, k0, 32 + sr); S.sf3 = *(const f32x4*)(ROW(p, k0, 32 + sr) + 4); } while (0)
#define SWRITE_KF(bf) do { *(bf16x8*)(K_lds + (bf) * SHM_K + kws) = pack8(S.sf0, S.sf1); *(bf16x8*)(K_lds + (bf) * SHM_K + kws + 32 * 256) = pack8(S.sf2, S.sf3); } while (0)
#define SWRITE_VF(bf) do { *(bf16x8*)(V_lds + (bf) * SHM_V + vst0) = pack8(S.sf0, S.sf1); *(bf16x8*)(V_lds + (bf) * SHM_V + vst1) = pack8(S.sf2, S.sf3); } while (0)
template <class TIn, class TOut>
__device__ __forceinline__ void causal_swa_prime(const BlockRef<TIn, TOut>& cur, int W, char* lds, Seam<TIn>& S, int tid_in) {
    constexpr bool F32 = same_t<TIn, float>::v;
    const int tid = tid_in, wid = __builtin_amdgcn_readfirstlane(tid >> 6), lane = tid & 63, r32 = lane & 31, hi = lane >> 5;
    const int sr = tid >> 4, sc = (tid & 15) * 8, kws = KSWZ(sr, sc * 2); char* K_lds = lds + 2 * SHM_V;
    const int kb0 = swa_jlo(cur.P0, W) * KVBLK;
    for (int d0 = 0; d0 < 8; ++d0) S.qr[d0] = load8<TIn>(cur.Q + (size_t)(wid * QBLK + r32) * D + d0 * 16 + hi * 8);
    if constexpr (F32) { SLOAD_F((const float*)cur.K, kb0); VMW(); SWRITE_KF(0); SBAR(); SLOAD_F((const float*)cur.V, kb0); }
    else { SLOAD_H(cur.K, cur.V, kb0); VMW(); SWRITE_HK(0); }
    __syncthreads();
}
template <class TIn, class TOut>
__device__ __forceinline__ void causal_swa_block(const BlockRef<TIn, TOut>& cur, const BlockRef<TIn, TOut>& nxt, int skv, int W, char* lds, __attribute__((address_space(3))) unsigned char* lds_base3, Seam<TIn>& S, int tid_in) {
    constexpr bool F32 = same_t<TIn, float>::v;
    const int tid = tid_in, wid = __builtin_amdgcn_readfirstlane(tid >> 6), lane = tid & 63, r32 = lane & 31, hi = lane >> 5;
    const int j_lo = swa_jlo(cur.P0, W);
    int j_hi = (cur.P0 + QB - 1) / KVBLK + 1; if (j_hi > skv / KVBLK) j_hi = skv / KVBLK;
    const int NT = j_hi - j_lo;
    const int kbn = swa_jlo(nxt.P0, W) * KVBLK;
    const int qlo = cur.P0 + wid * QBLK, qm = qlo + r32 - 4 * hi;
    char* V_lds = lds; char* K_lds = lds + 2 * SHM_V;
    float* ws = (float*)(lds + 2 * SHM_V + 2 * SHM_K) + wid * 64; float* li_l = ws, * al_l = ws + 32;
    float m_reg = -1e30f, l_reg = 0; f32x16 o[4] = {};
    const int sr = tid >> 4, sc = (tid & 15) * 8, vst0 = v_st(sr, sc), vst1 = v_st(32 + sr, sc), kws = KSWZ(sr, sc * 2);
    const int vb0 = (int)(uintptr_t)V_lds + v_rd_base(lane);
    const TIn* Kh = cur.K; const TIn* Vh = cur.V;
#define RESC(a) do { if (__any((a) < 1.f)) { if (hi == 0) al_l[r32] = (a); asm volatile("s_waitcnt lgkmcnt(0)" ::: "memory");              \
                     for (int d_ = 0; d_ < 4; ++d_) for (int r = 0; r < 16; ++r) o[d_][r] *= al_l[crow(r, hi)]; } } while (0)
#define KBASE(t) ((j_lo + (t)) * KVBLK)
#define ACT(t) (KBASE(t) <= qlo + QBLK - 1 && KBASE(t) + KVBLK - 1 >= qlo - W + 1)
#define LDW(t) (cur.MW[(size_t)(wid * QBLK + r32) * 32 + j_lo + (t)])
#define MASKT(P0_, P1_, W_, t) do { const int kb_ = KBASE(t); mask_bias_tile(P0_, P1_, W_, strip + (qm - kb_ - 59 + 256), hi); } while (0)
    constexpr int NQL = F32 ? 16 : 8;
    constexpr bool SK = WSKIP && !F32;
#define SEAM_K0() do { VMWN(NQL); if constexpr (F32) { SWRITE_KF(0); SBAR(); SLOAD_F((const float*)nxt.V, kbn); } else { SWRITE_HK(0); } SBAR(); } while (0)
    f32x16 pA0, pA1, pB0, pB1; float mnA, mnB, alA, alB; bf16x8 pa0, pa1, pa2, pa3;
    const __attribute__((address_space(3))) float* strip = (const __attribute__((address_space(3))) float*)(lds_base3 + STRIP_OFF);
    unsigned long long wA = LDW(0), wB = NT > 1 ? LDW(1) : 0ull;
    if constexpr (F32) { VMW(); SWRITE_VF(0); SBAR(); } else { SWRITE_HV(0); SBAR(); }
    if (NT > 1) { if constexpr (F32) SLOAD_F((const float*)Kh, KBASE(1)); else SLOAD_H(Kh, Vh, KBASE(1)); }
    SBAR(); qkt<0, SK>(pA0, pA1, K_lds, r32, hi, S.qr, ACT(0));
    if constexpr (F32) { if (NT > 1) { VMW(); SWRITE_KF(1); SBAR(); SLOAD_F((const float*)Vh, KBASE(1)); } }
    MASKT(pA0, pA1, wA, 0); partialSM(pA0, pA1, m_reg, mnA, alA);
    if (NT > 1) { VMW(); if constexpr (F32) { SWRITE_VF(1); SBAR(); if (NT > 2) SLOAD_F((const float*)Kh, KBASE(2)); } else SWRITE_H(1); }
    __syncthreads();
#define HALF_STEP(PX0, PX1, mnX, alX, PY0, PY1, alY, WX, WY, t, KB, VB, SB) do {                                                      \
        if ((t) + 1 < NT) WY = LDW((t) + 1);                                                                                  \
        SBAR(); qkt<KB, SK>(PX0, PX1, K_lds, r32, hi, S.qr, ACT(t));                                             \
        finishSM(PY0, PY1, alY, l_reg, pa0, pa1, pa2, pa3); SBAR();                                                           \
        if ((t) + 1 < NT) { if constexpr (F32) { VMW(); SWRITE_KF(SB); SBAR(); SLOAD_F((const float*)Vh, KBASE((t) + 1)); }  \
                            else { SLOAD_H(Kh, Vh, KBASE((t) + 1)); } SBAR(); }                                               \
        pv_tile<VB, SK>(o, vb0, pa0, pa1, pa2, pa3, ACT((t) - 1)); MASKT(PX0, PX1, WX, (t)); partialSM(PX0, PX1, m_reg, mnX, alX);                                        \
        __syncthreads();                                                                                                      \
        if ((t) + 1 < NT) { VMW(); if constexpr (F32) { SWRITE_VF(SB); SBAR(); if ((t) + 2 < NT) SLOAD_F((const float*)Kh, KBASE((t) + 2)); } \
                            else { SWRITE_H(SB); } }                                                                          \
        RESC(alX); __syncthreads(); } while (0)
    for (int t = 1; t + 1 < NT; t += 2) {
        HALF_STEP(pB0, pB1, mnB, alB, pA0, pA1, alA, wB, wA, t, 1, 0, 0);
        HALF_STEP(pA0, pA1, mnA, alA, pB0, pB1, alB, wA, wB, t + 1, 0, 1, 1);
    }
    const bool even = (NT & 1) == 0;
    if (even) { SBAR(); qkt<1, SK>(pB0, pB1, K_lds, r32, hi, S.qr, ACT(NT - 1)); SBAR(); }
#define QROW(e) (nxt.Q + (size_t)(wid * QBLK + r32) * D + ((e) >> 1) * 16 + hi * 8 + ((e) & 1) * 4)
    if constexpr (F32) { SLOAD_F((const float*)nxt.K, kbn); SBAR();
#pragma unroll
        for (int e = 0; e < 8; ++e) S.tq[e] = *(const f32x4*)QROW(e); }
    else { SLOAD_H(nxt.K, nxt.V, kbn); SBAR();
#pragma unroll
        for (int d0 = 0; d0 < 8; ++d0) S.qr[d0] = load8<TIn>(nxt.Q + (size_t)(wid * QBLK + r32) * D + d0 * 16 + hi * 8); }
    SBAR();
    finishSM(pA0, pA1, alA, l_reg, pa0, pa1, pa2, pa3); SBAR();
    if constexpr (F32) {
#pragma unroll
        for (int e = 8; e < 16; ++e) S.tq[e] = *(const f32x4*)QROW(e); SBAR(); }
#undef QROW
    pv_tile<0, SK>(o, vb0, pa0, pa1, pa2, pa3, ACT(even ? NT - 2 : NT - 1));
    if (even) { MASKT(pB0, pB1, wB, NT - 1); partialSM(pB0, pB1, m_reg, mnB, alB); __syncthreads(); RESC(alB);
        finishSM(pB0, pB1, alB, l_reg, pa0, pa1, pa2, pa3); SBAR(); pv_tile<1, SK>(o, vb0, pa0, pa1, pa2, pa3, ACT(NT - 1)); }
    SBAR(); SEAM_K0();
    if (hi == 0) li_l[r32] = l_reg; asm volatile("s_waitcnt lgkmcnt(0)" ::: "memory");
    float rli[16];
#pragma unroll
    for (int r = 0; r < 16; ++r) rli[r] = __builtin_amdgcn_rcpf(li_l[crow(r, hi)]);
    TOut* Ow = cur.O + (size_t)(wid * QBLK) * OSTR;
#pragma unroll
    for (int r = 0; r < 16; ++r) { const int orow = crow(r, hi);
#pragma unroll
        for (int d0 = 0; d0 < 4; ++d0) { const float v = o[d0][r] * rli[r];
            if constexpr (same_t<TOut, float>::v) { Ow[(size_t)orow * OSTR + d0 * 32 + r32] = v; }
            else { const float vn = __shfl_xor(v, 1);
                   if ((r32 & 1) == 0) *(unsigned*)(Ow + (size_t)orow * OSTR + d0 * 32 + r32) = cvtpk(v, vn); } } }
    if constexpr (F32) {
#pragma unroll
        for (int d0 = 0; d0 < 8; ++d0) S.qr[d0] = pack8(S.tq[2 * d0], S.tq[2 * d0 + 1]); }
    __syncthreads();
#undef RESC
#undef KBASE
#undef ACT
#undef MASKT
#undef LDW
#undef SEAM_K0
#undef HALF_STEP
}
#undef ROW
#undef VMW
#undef VMWN
#undef SLOAD_H
#undef SWRITE_HK
#undef SWRITE_HV
#undef SWRITE_H
#undef SLOAD_F
#undef SWRITE_KF
#undef SWRITE_VF

}

constexpr int NWAVES = 8;
constexpr int NPH = 10;
constexpr int N_LAUNCHES = MK_N_LAUNCHES;
static_assert(N_LAUNCHES == 1 || N_LAUNCHES == NPH, "MK_N_LAUNCHES is 1 or 10");
constexpr int RING_OFF = 0, RING_BYTES = 131072;
constexpr int LDSCTL_OFF = RING_BYTES, MISC_OFF = LDSCTL_OFF + 320;
constexpr int LDS_BYTES = 147456;
static_assert(MISC_OFF + 128 <= LDS_BYTES, "LDS map");

constexpr size_t MiB = 1u << 20;
constexpr size_t al1(size_t x) { return (x + MiB - 1) / MiB * MiB; }
constexpr size_t WS_CTL = 0, CTL_ZERO_BYTES = 1 * MiB;
constexpr size_t WS_WINT = 2 * MiB;
constexpr size_t WS_WPAT = WS_WINT + al1((size_t)NINP * D * 2);
constexpr size_t WS_WPBT = WS_WPAT + al1((size_t)D * AW * 2);
constexpr size_t WS_WOT  = WS_WPBT + al1((size_t)D * CWD * 2);
constexpr size_t WS_W1T  = WS_WOT  + al1((size_t)D * D * 2);
constexpr size_t WS_W2T  = WS_W1T  + al1((size_t)FF * D * 2);
constexpr size_t WS_H    = WS_W2T  + al1((size_t)D * FF * 2);
constexpr size_t WS_QH   = WS_H    + al1((size_t)MPAD * D * 2);
constexpr size_t WS_KH   = WS_QH   + al1((size_t)MPR * AW * 2);
constexpr size_t WS_VH   = WS_KH   + al1((size_t)MPR * AW * 2);
constexpr size_t WS_QI   = WS_VH   + al1((size_t)MPR * AW * 2);
static_assert(WS_KH - WS_QH == (size_t)MPR * AW * 2 && WS_VH - WS_KH == (size_t)MPR * AW * 2, "QH | KH | VH contiguous");
constexpr size_t WS_KIB  = WS_QI   + al1((size_t)MPAD * 1024 * 2);
constexpr size_t WS_WI   = WS_KIB  + al1((size_t)MPAD * IDM * 2);
constexpr size_t WS_CXB  = WS_WI   + al1((size_t)MPAD * IH * 4);
constexpr size_t WS_SGA  = WS_CXB  + al1((size_t)3 * MPAD * CWD * 2);
constexpr size_t WS_SGB  = WS_SGA  + al1((size_t)MPAD * D * 2);
constexpr size_t WS_MASK = WS_SGB  + al1((size_t)MPAD * D * 2);
constexpr size_t WS_ATT  = WS_MASK + al1((size_t)MPR * 32 * 8);
constexpr size_t WS_CBY  = WS_ATT  + al1((size_t)MPAD * AW * 2);
constexpr size_t WS_MX   = WS_CBY  + al1((size_t)MPAD * CWD * 2);
constexpr size_t WS_X2   = WS_MX   + al1((size_t)MPAD * D * 2);
constexpr size_t WS_XB   = WS_X2   + al1((size_t)MPAD * D * 4);
constexpr size_t WS_HID  = WS_XB   + al1((size_t)MPAD * D * 2);
constexpr size_t WS_QS   = WS_HID  + al1((size_t)MPAD * FF * 2);
constexpr size_t WS_SSC  = WS_QS   + al1((size_t)MS * AW * 4);
constexpr size_t WS_SEL  = WS_SSC  + al1((size_t)MS * SSTR * 4);
constexpr size_t WS_END  = WS_SEL  + al1((size_t)MS * TOPK * 4);
constexpr int CW_TMO = 0, CW_CODE = 1;
constexpr int CW_BAR = 4096;
constexpr int CW_SSQ1 = 16384, CW_SSQ2 = 32768;
static_assert((CW_SSQ2 + MPAD) * 4 <= (int)CTL_ZERO_BYTES && CW_BAR + 3456 <= CW_SSQ1 && CW_SSQ1 + MPAD <= CW_SSQ2, "CTL map");

struct Frame {
    LAS unsigned char* lds;
    volatile LAS unsigned* MISC;
    gu32* ctl;
    int tid, lane, wave, vcu, G;
};

__device__ __forceinline__ float wave_sum(float v) {
#pragma unroll
    for (int o = 1; o < 64; o <<= 1) v += __shfl_xor(v, o);
    return v;
}

template <int MODE>
__device__ __forceinline__ void p0_transpose_item(const float* W, int K, int Nsrc, int Ndst, bf16* WT, const float* g, LAS float* scr, int item, int lane) {
    const int nblk = Ndst / 32, kb = item / nblk, nb = item % nblk, k0 = 64 * kb, n0 = 32 * nb;
    const int n = n0 + (lane & 31);
    int src = n; if (MODE == 1) src = n < 4176 ? n : (n >= 4352 ? n - 176 : -1);
#pragma unroll 8
    for (int i = 0; i < 32; ++i) { const int kk = 2 * i + (lane >> 5); float v = 0.f; if (src >= 0) v = W[(size_t)(k0 + kk) * Nsrc + src]; if (MODE == 2) v *= g[k0 + kk]; scr[kk * 33 + (lane & 31)] = v; }
    LDS_WAIT(); asm volatile("" ::: "memory");
    const int c = lane & 7;
#pragma unroll
    for (int j = 0; j < 4; ++j) { const int nn = (lane >> 3) + 8 * j; const LAS float* s = scr + (8 * c) * 33 + nn;
        v4u o; o.x = cvt_pk_bf16(s[0 * 33], s[1 * 33]); o.y = cvt_pk_bf16(s[2 * 33], s[3 * 33]); o.z = cvt_pk_bf16(s[4 * 33], s[5 * 33]); o.w = cvt_pk_bf16(s[6 * 33], s[7 * 33]);
        *(GAS v4u*)(WT + (size_t)(n0 + nn) * K + k0 + 8 * c) = o; }
    LDS_WAIT(); asm volatile("" ::: "memory");
}
__device__ __forceinline__ void rms_row_to_bf16(const float* xrow, const float* g, bf16* orow, int lane) {
    const GAS f32x4* xr = (const GAS f32x4*)xrow + lane; const GAS f32x4* gr = (const GAS f32x4*)g + lane;
    f32x4 v[8]; float s = 0.f;
#pragma unroll
    for (int j = 0; j < 8; ++j) { v[j] = xr[64 * j]; s += (v[j].x * v[j].x + v[j].y * v[j].y) + (v[j].z * v[j].z + v[j].w * v[j].w); }
    const float rs = 1.0f / sqrtf(wave_sum(s) * (1.0f / D) + EPS);
    GAS v2u* o8 = (GAS v2u*)orow + lane;
#pragma unroll
    for (int j = 0; j < 8; ++j) { const f32x4 gg = gr[64 * j]; v2u w; w.x = cvt_pk_bf16(v[j].x * rs * gg.x, v[j].y * rs * gg.y); w.y = cvt_pk_bf16(v[j].z * rs * gg.z, v[j].w * rs * gg.w); o8[64 * j] = w; }
}
struct P0Args { const float *xp, *xs, *gmix, *win, *wpa, *wpb, *wo, *gmlp, *w1, *w2; bf16 *WinT, *WpaT, *WpbT, *WoT, *W1T, *W2T, *H; };
__device__ __forceinline__ void p0_prologue(Frame& F, const P0Args& a) {
    LAS float* scr = (LAS float*)(F.lds + RING_OFF + F.wave * 16384);
    const int gw = F.vcu * NWAVES + F.wave, NGW = F.G * NWAVES;
    constexpr int I_IN = (D / 64) * (NINP / 32), I_PA = (AW / 64) * (D / 32), I_PB = (CWD / 64) * (D / 32), I_O = (D / 64) * (D / 32), I_1 = (D / 64) * (FF / 32), I_2 = (FF / 64) * (D / 32);
    constexpr int NITEMS = I_IN + I_PA + I_PB + I_O + I_1 + I_2;
    for (int it = gw; it < NITEMS; it += NGW) {
        int r = it;
        if (r < I_IN) { p0_transpose_item<1>(a.win, D, NIN, NINP, a.WinT, nullptr, scr, r, F.lane); continue; } r -= I_IN;
        if (r < I_PA) { p0_transpose_item<0>(a.wpa, AW, D, D, a.WpaT, nullptr, scr, r, F.lane); continue; } r -= I_PA;
        if (r < I_PB) { p0_transpose_item<0>(a.wpb, CWD, D, D, a.WpbT, nullptr, scr, r, F.lane); continue; } r -= I_PB;
        if (r < I_O)  { p0_transpose_item<0>(a.wo, D, D, D, a.WoT, nullptr, scr, r, F.lane); continue; } r -= I_O;
        if (r < I_1)  { p0_transpose_item<2>(a.w1, D, FF, FF, a.W1T, a.gmlp, scr, r, F.lane); continue; } r -= I_1;
        p0_transpose_item<0>(a.w2, FF, D, D, a.W2T, nullptr, scr, r, F.lane);
    }
    for (int m = gw; m < MPAD; m += NGW) {
        if (m < MPR) rms_row_to_bf16(a.xp + (size_t)m * D, a.gmix, a.H + (size_t)m * D, F.lane);
        else if (m < MTOT) rms_row_to_bf16(a.xs + (size_t)(m - MPR) * D, a.gmix, a.H + (size_t)m * D, F.lane);
        else { GAS v4u* o = (GAS v4u*)(a.H + (size_t)m * D) + F.lane;
#pragma unroll
            for (int j = 0; j < 4; ++j) o[64 * j] = (v4u){0u, 0u, 0u, 0u}; }
    }
}

__device__ __forceinline__ int rel_bucket(int n) {
    if (n < 16) return n < 0 ? 0 : n;
    int l = 16 + (int)(logf((float)n * (1.0f / 16.0f)) / 2.0794415416798357f * 16.0f);
    return l > 31 ? 31 : l;
}

__device__ __forceinline__ unsigned mono_key(float f) { const unsigned u = __float_as_uint(f); return (u & 0x80000000u) ? ~u : (u | 0x80000000u); }
__device__ __forceinline__ void idx_unit(LAS unsigned char* lds, const bf16* QI, const bf16* KIB, const float* WI, u64* MASKW, int b, int blk, int tid, int wid, int lane) {
    const int t0 = blk * 16 + 2 * wid, r = lane & 31, hf = lane >> 5;
    const int tokA = (r >> 2) & 1, headA = (r & 3) + 4 * (r >> 3);
    const bf16* qp = QI + (size_t)(b * T + t0 + tokA) * 1024 + headA * IDM + 8 * hf;
    bf16x8 af[4];
#pragma unroll
    for (int i = 0; i < 4; ++i) af[i] = *(const bf16x8*)(qp + 16 * i);
    const float* wp = WI + (size_t)(b * T + t0 + hf) * IH;
    f32x4 w4[4];
#pragma unroll
    for (int i = 0; i < 4; ++i) w4[i] = *(const f32x4*)(wp + 4 * i);
    const int nkeys = blk * 16 + 16, nch = (nkeys + 255) >> 8;
    const int ntw = ((t0 + 1) >> 5) + 1;
    const int tme = t0 + hf;
    unsigned skey[64];
    const bf16* kbase = KIB + (size_t)b * T * IDM;
    v4u st[4];
#pragma unroll
    for (int i = 0; i < 4; ++i) st[i] = *(const v4u*)(kbase + (size_t)(tid + 512 * i) * 8);
#pragma unroll
    for (int i = 0; i < 4; ++i) { const int p = tid + 512 * i, key = p >> 3, c16 = p & 7; *(LAS v4u*)(lds + key * 128 + ((c16 ^ (key & 7)) << 4)) = st[i]; }
    __syncthreads();
#pragma unroll
    for (int c = 0; c < 8; ++c) {
        if (c < nch) {
            if (c + 1 < nch) {
#pragma unroll
                for (int i = 0; i < 4; ++i) st[i] = *(const v4u*)(kbase + (size_t)(c + 1) * 256 * IDM + (size_t)(tid + 512 * i) * 8);
            }
            const LAS unsigned char* kb = lds + (c & 1) * 32768;
#pragma unroll
            for (int jt = 0; jt < 8; ++jt) { const int j = 8 * c + jt;
                if (j < ntw) {
                    const int kl = 32 * jt + r;
                    bf16x8 bfr[4];
#pragma unroll
                    for (int i = 0; i < 4; ++i) bfr[i] = *(const LAS bf16x8*)(kb + kl * 128 + (((2 * i + hf) ^ (kl & 7)) << 4));
                    f32x16 acc = {};
#pragma unroll
                    for (int i = 0; i < 4; ++i) acc = __builtin_amdgcn_mfma_f32_32x32x16_bf16(af[i], bfr[i], acc, 0, 0, 0);
                    float s0 = 0.f, s1 = 0.f;
#pragma unroll
                    for (int q = 0; q < 4; ++q) { s0 = fmaf(w4[q][0], fmaxf(acc[4 * q + 0], 0.f), s0); s1 = fmaf(w4[q][1], fmaxf(acc[4 * q + 1], 0.f), s1);
                                                  s0 = fmaf(w4[q][2], fmaxf(acc[4 * q + 2], 0.f), s0); s1 = fmaf(w4[q][3], fmaxf(acc[4 * q + 3], 0.f), s1); }
                    const int key = 32 * j + r;
                    skey[j] = key <= tme ? mono_key(s0 + s1) : 0u;
                } else skey[j] = 0u;
            }
            if (c + 1 < nch) {
#pragma unroll
                for (int i = 0; i < 4; ++i) { const int p = tid + 512 * i, key = p >> 3, c16 = p & 7; *(LAS v4u*)(lds + ((c + 1) & 1) * 32768 + key * 128 + ((c16 ^ (key & 7)) << 4)) = st[i]; }
            }
            __syncthreads();
        } else {
#pragma unroll
            for (int jt = 0; jt < 8; ++jt) skey[8 * c + jt] = 0u;
        }
    }
    const int ng = (ntw + 7) >> 3;
    unsigned prefix = 0u;
    if (t0 + 1 >= TOPK) {
        for (int bit = 31; bit >= 0; --bit) {
            const unsigned cand = prefix | (1u << bit);
            int cA = 0, cB = 0;
#pragma unroll
            for (int g = 0; g < 8; ++g) if (g < ng) {
#pragma unroll
                for (int jj = 0; jj < 8; ++jj) { const u64 mm = __ballot(skey[8 * g + jj] >= cand); cA += __popc((unsigned)mm); cB += __popc((unsigned)(mm >> 32)); } }
            const int cnt = hf ? cB : cA;
            if (cnt >= TOPK) prefix = cand;
        }
    }
    const unsigned theta = (tme < TOPK) ? 1u : prefix;
    u64* mwA = MASKW + (size_t)(b * T + t0) * 32; u64* mwB = mwA + 32;
#pragma unroll
    for (int g = 0; g < 8; ++g) {
        if (g < ng) {
#pragma unroll
            for (int jj = 0; jj < 4; ++jj) { const int j2 = 4 * g + jj;
                const u64 m0 = __ballot(skey[2 * j2] >= theta), m1 = __ballot(skey[2 * j2 + 1] >= theta);
                const u64 wA = (m0 & 0xffffffffull) | (m1 << 32), wB = (m0 >> 32) | (m1 & 0xffffffff00000000ull);
                if (lane == 0) mwA[j2] = wA;
                if (lane == 32) mwB[j2] = wB; }
        } else {
            if (lane < 4) mwA[4 * g + lane] = 0ull;
            if (lane >= 32 && lane < 36) mwB[4 * g + lane - 32] = 0ull;
        }
    }
}

__device__ __forceinline__ void sidx_tile(const bf16x8 (&af)[2][4], const float* kr, bool f32src, const bf16* krb, const f32x4 (&w4)[2][4], float (&sc)[2], int hf) {
    bf16x8 bfr[4];
#pragma unroll
    for (int i = 0; i < 4; ++i) {
        if (f32src) { const f32x4 a = *(const f32x4*)(kr + 16 * i + 8 * hf), c = *(const f32x4*)(kr + 16 * i + 8 * hf + 4); const v4u p = pack8(a, c); bfr[i] = *(const bf16x8*)&p; }
        else bfr[i] = *(const bf16x8*)(krb + 16 * i + 8 * hf);
    }
#pragma unroll
    for (int pr = 0; pr < 2; ++pr) {
        f32x16 acc = {};
#pragma unroll
        for (int i = 0; i < 4; ++i) acc = __builtin_amdgcn_mfma_f32_32x32x16_bf16(af[pr][i], bfr[i], acc, 0, 0, 0);
        float s0 = 0.f, s1 = 0.f;
#pragma unroll
        for (int q = 0; q < 4; ++q) { s0 = fmaf(w4[pr][q][0], fmaxf(acc[4 * q + 0], 0.f), s0); s1 = fmaf(w4[pr][q][1], fmaxf(acc[4 * q + 1], 0.f), s1);
                                      s0 = fmaf(w4[pr][q][2], fmaxf(acc[4 * q + 2], 0.f), s0); s1 = fmaf(w4[pr][q][3], fmaxf(acc[4 * q + 3], 0.f), s1); }
        sc[pr] = s0 + s1;
    }
}
__device__ __forceinline__ void sidx_unit(const bf16* QI, const bf16* KIB, const float* WI, const float* ckidx, const int* ptab, float* SSC, int b, int chunk, int wid, int lane) {
    const int r = lane & 31, hf = lane >> 5;
    const int tokA = (r >> 2) & 1, headA = (r & 3) + 4 * (r >> 3);
    bf16x8 af[2][4]; f32x4 w4[2][4];
#pragma unroll
    for (int pr = 0; pr < 2; ++pr) {
        const bf16* qp = QI + (size_t)(MPR + b * DT + 2 * pr + tokA) * 1024 + headA * IDM + 8 * hf;
        const float* wp = WI + (size_t)(MPR + b * DT + 2 * pr + hf) * IH;
#pragma unroll
        for (int i = 0; i < 4; ++i) { af[pr][i] = *(const bf16x8*)(qp + 16 * i); w4[pr][i] = *(const f32x4*)(wp + 4 * i); }
    }
#pragma unroll
    for (int tl = 0; tl < 2; ++tl) {
        const int s = chunk * 512 + wid * 64 + tl * 32 + r;
        const int phys = ptab[b * NPAGES + (s >> 7)];
        const float* kr = ckidx + ((size_t)phys * PAGE + (s & 127)) * IDM;
        float sc[2];
        sidx_tile(af, kr, true, nullptr, w4, sc, hf);
        SSC[(size_t)(b * DT + hf) * SSTR + s] = sc[0];
        SSC[(size_t)(b * DT + 2 + hf) * SSTR + s] = sc[1];
    }
    if (chunk == 0 && wid == 0) {
        const int n = r < DT ? r : DT - 1;
        float sc[2];
        sidx_tile(af, nullptr, false, KIB + (size_t)(MPR + b * DT + n) * IDM, w4, sc, hf);
        if (r < DT) { SSC[(size_t)(b * DT + hf) * SSTR + PAST + r] = sc[0]; SSC[(size_t)(b * DT + 2 + hf) * SSTR + PAST + r] = sc[1]; }
    }
}

struct ConvArgs { const bf16* CXB; const float* convw; const float* sconv; bf16* CBY; float* out; };
__device__ __forceinline__ void unpack8(const v4u w, float (&f)[8]) { f[0] = bf_lo(w.x); f[1] = bf_hi(w.x); f[2] = bf_lo(w.y); f[3] = bf_hi(w.y); f[4] = bf_lo(w.z); f[5] = bf_hi(w.z); f[6] = bf_lo(w.w); f[7] = bf_hi(w.w); }
__device__ __forceinline__ void conv_items(Frame& F, const ConvArgs& a) {
    const bf16* CX = a.CXB; const bf16* CB = a.CXB + (size_t)MPAD * CWD; const bf16* CC = a.CXB + (size_t)2 * MPAD * CWD;
    const long gt = (long)F.vcu * 512 + F.tid, NGT = (long)F.G * 512;
    for (long it = gt; it < (long)MTOT * 128; it += NGT) {
        const int row = (int)(it >> 7), c0 = (int)(it & 127) * 8;
        float w0[8], w1[8], w2[8];
#pragma unroll
        for (int j = 0; j < 8; ++j) { w0[j] = a.convw[c0 + j]; w1[j] = a.convw[CWD + c0 + j]; w2[j] = a.convw[2 * CWD + c0 + j]; }
        float u[3][8];
        const bool samp = row >= MPR; const int tt = samp ? ((row - MPR) & (DT - 1)) : (row & (T - 1));
#pragma unroll
        for (int k = 0; k < 3; ++k) {
            const int ts = tt - 2 + k;
            if (ts >= 0) { float a8[8], b8[8]; unpack8(*(const v4u*)(CX + (size_t)(row - 2 + k) * CWD + c0), a8); unpack8(*(const v4u*)(CC + (size_t)(row - 2 + k) * CWD + c0), b8);
#pragma unroll
                for (int j = 0; j < 8; ++j) u[k][j] = a8[j] * b8[j]; }
            else if (samp) { const int bb = (row - MPR) >> 2; const float* sp = a.sconv + ((size_t)bb * 2 + (ts + 2)) * CWD + c0;
#pragma unroll
                for (int j = 0; j < 8; ++j) u[k][j] = sp[j]; }
            else {
#pragma unroll
                for (int j = 0; j < 8; ++j) u[k][j] = 0.f; }
        }
        float cb8[8]; unpack8(*(const v4u*)(CB + (size_t)row * CWD + c0), cb8);
        f32x4 y0, y1;
#pragma unroll
        for (int j = 0; j < 4; ++j) { y0[j] = cb8[j] * (w0[j] * u[0][j] + w1[j] * u[1][j] + w2[j] * u[2][j]); y1[j] = cb8[4 + j] * (w0[4 + j] * u[0][4 + j] + w1[4 + j] * u[1][4 + j] + w2[4 + j] * u[2][4 + j]); }
        *(v4u*)(a.CBY + (size_t)row * CWD + c0) = pack8(y0, y1);
        float* so = nullptr;
        if (!samp) { if (tt >= T - 2) so = a.out + OUT_CONV + ((size_t)(row >> 11) * 2 + (tt - (T - 2))) * CWD + c0; }
        else if (tt >= DT - 2) so = a.out + OUT_CONVS + ((size_t)((row - MPR) >> 2) * 2 + (tt - (DT - 2))) * CWD + c0;
        if (so) {
#pragma unroll
            for (int j = 0; j < 8; ++j) so[j] = u[2][j]; }
    }
}

__device__ __forceinline__ void ssel_unit(LAS unsigned char* lds, const float* SSC, int* SEL, int q, int tid, int wid, int lane) {
    LAS int* cw = (LAS int*)lds;
    asm volatile("" : "+v"(tid));
    const int tq = q & (DT - 1);
    unsigned v[33];
#pragma unroll
    for (int i = 0; i < 33; ++i) { const int idx = tid + 512 * i; unsigned k = 0u;
        if (idx < PAST || (idx < NKS && idx - PAST <= tq)) k = mono_key(SSC[(size_t)q * SSTR + idx]);
        v[i] = k; }
    unsigned prefix = 0u;
    for (int bit = 31; bit >= 0; --bit) {
        const unsigned cand = prefix | (1u << bit);
        int c = 0;
#pragma unroll
        for (int i = 0; i < 33; ++i) { c += __popcll(__ballot(v[i] >= cand)); if ((i & 7) == 7) __builtin_amdgcn_sched_barrier(0); }
        const int par = bit & 1;
        if (lane == 0) cw[par * 8 + wid] = c;
        __syncthreads();
        int tot = 0;
#pragma unroll
        for (int w = 0; w < 8; ++w) tot += cw[par * 8 + w];
        if (tot >= TOPK) prefix = cand;
    }
    const unsigned theta = prefix;
    int mycnt = 0;
#pragma unroll
    for (int i = 0; i < 33; ++i) { mycnt += __popcll(__ballot(v[i] >= theta)); if ((i & 7) == 7) __builtin_amdgcn_sched_barrier(0); }
    __syncthreads();
    if (lane == 0) cw[64 + wid] = mycnt;
    __syncthreads();
    int base = 0;
#pragma unroll
    for (int w = 0; w < 8; ++w) if (w < wid) base += cw[64 + w];
    const u64 ltmask = (1ull << lane) - 1ull;
#pragma unroll
    for (int i = 0; i < 33; ++i) { const u64 mm = __ballot(v[i] >= theta);
        if (v[i] >= theta) { const int pos = base + __popcll(mm & ltmask); if (pos < TOPK) SEL[q * TOPK + pos] = tid + 512 * i; }
        base += __popcll(mm); if ((i & 3) == 3) __builtin_amdgcn_sched_barrier(0); }
    __syncthreads();
}

struct SAttArgs { const float *QS, *knew, *vnew, *ck, *cv, *relb; const int *ptab, *SEL; bf16* ATT; };
__device__ __forceinline__ void satt_unit(LAS unsigned char* lds, const SAttArgs& a, int q, int h, int tid, int wid, int lane) {
    LAS float* lg = (LAS float*)lds;
    LAS float* red = lg + 256;
    LAS float* part = lg + 512;
    LAS int* rowoff = (LAS int*)(lg + 1024);
    const int b = q >> 2, tq = q & 3, qpos = PAST + tq;
    if (tid < TOPK) { const int s = a.SEL[q * TOPK + tid]; int ro;
        if (s < PAST) ro = a.ptab[b * NPAGES + (s >> 7)] * PAGE + (s & 127); else ro = -(1 + (s - PAST));
        rowoff[tid] = ro;
        lg[tid] = a.relb[rel_bucket(qpos - s) * NH + h]; }
    __syncthreads();
    const int l16 = lane & 15, kq = lane >> 4;
    const f32x4 q0 = *(const f32x4*)(a.QS + (size_t)q * AW + h * HD + 8 * l16), q1 = *(const f32x4*)(a.QS + (size_t)q * AW + h * HD + 8 * l16 + 4);
#pragma unroll
    for (int i = 0; i < 8; ++i) { const int k = 32 * wid + 4 * i + kq; const int ro = rowoff[k];
        const float* kr = ro >= 0 ? a.ck + ((size_t)ro * NH + h) * HD : a.knew + ((size_t)(b * DT + (-ro - 1))) * AW + h * HD;
        const f32x4 k0 = *(const f32x4*)(kr + 8 * l16), k1 = *(const f32x4*)(kr + 8 * l16 + 4);
        float d = (q0[0] * k0[0] + q0[1] * k0[1]) + (q0[2] * k0[2] + q0[3] * k0[3]) + (q1[0] * k1[0] + q1[1] * k1[1]) + (q1[2] * k1[2] + q1[3] * k1[3]);
        d += __shfl_xor(d, 1); d += __shfl_xor(d, 2); d += __shfl_xor(d, 4); d += __shfl_xor(d, 8);
        if (l16 == 0) lg[k] = lg[k] + d * 0.08838834764831845f; }
    __syncthreads();
    float mx = fmaxf(fmaxf(lg[lane], lg[lane + 64]), fmaxf(lg[lane + 128], lg[lane + 192]));
#pragma unroll
    for (int o = 1; o < 64; o <<= 1) mx = fmaxf(mx, __shfl_xor(mx, o));
    const float e0 = __expf(lg[lane] - mx), e1 = __expf(lg[lane + 64] - mx), e2 = __expf(lg[lane + 128] - mx), e3 = __expf(lg[lane + 192] - mx);
    const float ssum = wave_sum((e0 + e1) + (e2 + e3));
    __syncthreads();
    if (wid == 0) { lg[lane] = e0; lg[lane + 64] = e1; lg[lane + 128] = e2; lg[lane + 192] = e3; }
    __syncthreads();
    const int g = tid >> 7, d = tid & 127; float o = 0.f;
#pragma unroll 8
    for (int k = 64 * g; k < 64 * g + 64; ++k) { const int ro = rowoff[k];
        const float* vr = ro >= 0 ? a.cv + ((size_t)ro * NH + h) * HD : a.vnew + ((size_t)(b * DT + (-ro - 1))) * AW + h * HD;
        o = fmaf(lg[k], vr[d], o); }
    part[g * 128 + d] = o;
    __syncthreads();
    if (tid < 128) { const float r = ((part[tid] + part[128 + tid]) + (part[256 + tid] + part[384 + tid])) / ssum;
        a.ATT[(size_t)(MPR + q) * AW + h * HD + tid] = (bf16)(cvt_pk_bf16(r, 0.f) & 0xffffu); }
    __syncthreads();
    (void)red;
}

__device__ __forceinline__ void final_norm(Frame& F, float* out, const float* SSQ2, const float* gf) {
    const int gw = F.vcu * NWAVES + F.wave, NGW = F.G * NWAVES;
    for (int m = gw; m < MTOT; m += NGW) {
        float* row = m < MPR ? out + OUT_Y + (size_t)m * D : out + OUT_YS + (size_t)(m - MPR) * D;
        const float rs = 1.0f / sqrtf(__hip_atomic_load(SSQ2 + m, RLX_AGENT) * (1.0f / D) + EPS);
        GAS f32x4* xr = (GAS f32x4*)row + F.lane; const GAS f32x4* gr = (const GAS f32x4*)gf + F.lane;
#pragma unroll
        for (int j = 0; j < 8; ++j) { const f32x4 v = xr[64 * j], gg = gr[64 * j]; xr[64 * j] = v * rs * gg; }
    }
}

struct Args { const void* in[18]; float* out; unsigned char* ws; int ph_lo, ph_hi; };

template <int PH_LO, int PH_HI>
__global__ void __launch_bounds__(NWAVES * 64, 2) fwd(Args args) {
    extern __shared__ __attribute__((aligned(16))) unsigned char lds[];
    Frame F;
    F.lds = (LAS unsigned char*)lds;
    F.MISC = (volatile LAS unsigned*)(F.lds + MISC_OFF);
    const int wave0 = __builtin_amdgcn_readfirstlane(threadIdx.x >> 6);
    F.tid = threadIdx.x; F.lane = F.tid & 63; F.wave = wave0;
    F.G = gridDim.x; { const int bx = blockIdx.x; F.vcu = (F.G % 8 == 0) ? (bx % 8) * (F.G / 8) + bx / 8 : bx; }
    typedef const __attribute__((address_space(4))) Args* ArgsP;
    ArgsP AP = (ArgsP)__builtin_amdgcn_kernarg_segment_ptr();
    F.ctl = (gu32*)(AP->ws + WS_CTL);
#define x_prompt ((const float*)AP->in[0])
#define x_sample ((const float*)AP->in[1])
#define cache_k ((const float*)AP->in[2])
#define cache_v ((const float*)AP->in[3])
#define cache_kidx ((const float*)AP->in[4])
#define state_conv ((const float*)AP->in[5])
#define page_table ((const int*)AP->in[6])
#define rel_bias ((const float*)AP->in[7])
#define norm_mix_g ((const float*)AP->in[8])
#define w_in ((const float*)AP->in[9])
#define conv_w ((const float*)AP->in[10])
#define w_pa ((const float*)AP->in[11])
#define w_pb ((const float*)AP->in[12])
#define w_o ((const float*)AP->in[13])
#define norm_mlp_g ((const float*)AP->in[14])
#define w_mlp_in ((const float*)AP->in[15])
#define w_mlp_out ((const float*)AP->in[16])
#define norm_final_g ((const float*)AP->in[17])
#define out (AP->out)
#define WinT ((bf16*)(AP->ws + WS_WINT))
#define WpaT ((bf16*)(AP->ws + WS_WPAT))
#define WpbT ((bf16*)(AP->ws + WS_WPBT))
#define WoT ((bf16*)(AP->ws + WS_WOT))
#define W1T ((bf16*)(AP->ws + WS_W1T))
#define W2T ((bf16*)(AP->ws + WS_W2T))
#define HBUF ((bf16*)(AP->ws + WS_H))
#define QH ((bf16*)(AP->ws + WS_QH))
#define KH ((bf16*)(AP->ws + WS_KH))
#define VH ((bf16*)(AP->ws + WS_VH))
#define QI ((bf16*)(AP->ws + WS_QI))
#define KIB ((bf16*)(AP->ws + WS_KIB))
#define WI ((float*)(AP->ws + WS_WI))
#define CXB ((bf16*)(AP->ws + WS_CXB))
#define SGA ((bf16*)(AP->ws + WS_SGA))
#define SGB ((bf16*)(AP->ws + WS_SGB))
#define MASKW ((u64*)(AP->ws + WS_MASK))
#define ATT ((bf16*)(AP->ws + WS_ATT))
#define CBY ((bf16*)(AP->ws + WS_CBY))
#define MX ((bf16*)(AP->ws + WS_MX))
#define X2 ((float*)(AP->ws + WS_X2))
#define XB ((bf16*)(AP->ws + WS_XB))
#define HID ((bf16*)(AP->ws + WS_HID))
#define QS ((float*)(AP->ws + WS_QS))
#define SSC ((float*)(AP->ws + WS_SSC))
#define SEL ((int*)(AP->ws + WS_SEL))
#define SSQ1 ((float*)(AP->ws + WS_CTL) + CW_SSQ1)
#define SSQ2 ((float*)(AP->ws + WS_CTL) + CW_SSQ2)

    for (int u = F.tid; u < (LDS_BYTES - LDSCTL_OFF) / 4; u += NWAVES * 64) ((LAS unsigned*)(F.lds + LDSCTL_OFF))[u] = 0u;
    __syncthreads();
    XcdBarrier bar; bar.bar = (unsigned*)(F.ctl + CW_BAR); bar.x = 0; bar.st = nullptr; bar.w0 = wave0;
    if (N_LAUNCHES == 1) bar = xcd_barrier_post((unsigned*)(F.ctl + CW_BAR), F.MISC + 8);
#define GRID_BAR() do { if (N_LAUNCHES == 1) xcd_barrier(bar); } while (0)
    constexpr int lo = PH_LO, hi = PH_HI;
#ifndef PHASE_MASK
#define PHASE_MASK 0x3ff
#endif
#define IN(k) (((PHASE_MASK >> (k)) & 1) && lo <= (k) && (k) < hi)
#define BOTH(k) (IN(k) && IN((k) + 1))

    if (IN(0)) { F.tid = wave0 * 64 + (int)__builtin_amdgcn_mbcnt_hi(~0u, __builtin_amdgcn_mbcnt_lo(~0u, 0u)); asm volatile("" : "+v"(F.tid)); asm volatile("" : "+s"(AP)); F.lane = F.tid & 63; F.wave = __builtin_amdgcn_readfirstlane(F.tid >> 6); asm volatile("; PHASE_MARK 0" ::: "memory");
        P0Args a{x_prompt, x_sample, norm_mix_g, w_in, w_pa, w_pb, w_o, norm_mlp_g, w_mlp_in, w_mlp_out, WinT, WpaT, WpbT, WoT, W1T, W2T, HBUF};
        p0_prologue(F, a);
        if (BOTH(0)) GRID_BAR();
    }
    if (IN(1)) { F.tid = wave0 * 64 + (int)__builtin_amdgcn_mbcnt_hi(~0u, __builtin_amdgcn_mbcnt_lo(~0u, 0u)); asm volatile("" : "+v"(F.tid)); asm volatile("" : "+s"(AP)); F.lane = F.tid & 63; F.wave = __builtin_amdgcn_readfirstlane(F.tid >> 6); asm volatile("; PHASE_MARK 1" ::: "memory");
        pg8::Gemm g{HBUF, WinT, HBUF, WinT, D}; pg8::StaticOrder S; S.init(MPAD, NINP, F.G, (int)blockIdx.x);
        EpiInProj E{out, QH, KH, VH, QI, KIB, CXB, SGA, SGB, WI, QS};
        pg8::gemm_phase<EpiInProj, pg8::StaticOrder, PG8_ALIGN, PG8_SP2>(F.lds + RING_OFF, g, S, E, F.tid);
        if (BOTH(1)) GRID_BAR();
    }
    if (IN(2)) { F.tid = wave0 * 64 + (int)__builtin_amdgcn_mbcnt_hi(~0u, __builtin_amdgcn_mbcnt_lo(~0u, 0u)); asm volatile("" : "+v"(F.tid)); asm volatile("" : "+s"(AP)); F.lane = F.tid & 63; F.wave = __builtin_amdgcn_readfirstlane(F.tid >> 6); asm volatile("; PHASE_MARK 2" ::: "memory");
        for (int L = F.vcu; L < 256; L += F.G) {
            idx_unit(F.lds, QI, KIB, WI, MASKW, L >> 7, L & 127, F.tid, F.wave, F.lane);
            const int L2 = 511 - L;
            idx_unit(F.lds, QI, KIB, WI, MASKW, L2 >> 7, L2 & 127, F.tid, F.wave, F.lane);
        }
        for (int L = F.vcu; L < 256; L += F.G) sidx_unit(QI, KIB, WI, cache_kidx, page_table, SSC, L >> 5, L & 31, F.wave, F.lane);
        ConvArgs ca{CXB, conv_w, state_conv, CBY, out};
        conv_items(F, ca);
        if (BOTH(2)) GRID_BAR();
    }
    if (IN(3)) { F.tid = wave0 * 64 + (int)__builtin_amdgcn_mbcnt_hi(~0u, __builtin_amdgcn_mbcnt_lo(~0u, 0u)); asm volatile("" : "+v"(F.tid)); asm volatile("" : "+s"(AP)); F.lane = F.tid & 63; F.wave = __builtin_amdgcn_readfirstlane(F.tid >> 6); asm volatile("; PHASE_MARK 3" ::: "memory");
        typedef att::BlockRef<bf16, bf16> BR;
        auto mkref = [&](int L) { const int bh = L >> 3, qb = L & 7, b = bh >> 3, h = bh & 7; BR r;
            r.Q = QH + ((size_t)bh * T + (size_t)qb * 256) * HD; r.K = KH + (size_t)bh * T * HD; r.V = VH + (size_t)bh * T * HD;
            r.O = ATT + ((size_t)b * T + (size_t)qb * 256) * AW + h * HD; r.P0 = qb * 256; r.MW = MASKW + ((size_t)b * T + (size_t)qb * 256) * 32; return r; };
        auto mkstrip = [&](int L) { const int h = (L >> 3) & 7; const float c31 = rel_bias[31 * NH + h];
            for (int i = F.tid; i < att::STRIP_N; i += NWAVES * 64) { const int dist = i - 256;
                ((LAS float*)(F.lds + att::STRIP_OFF))[i] = (dist >= 0 && dist < 113) ? (rel_bias[rel_bucket(dist) * NH + h] - c31) * (1.0f / att::SCALE) : 0.f; } };
        for (int L = F.vcu; L < 256; L += F.G) {
            const BR cur = mkref(L);
            att::Seam<bf16> S;
            mkstrip(L);
            att::causal_swa_prime<bf16, bf16>(cur, 1 << 30, (char*)lds, S, F.tid);
            att::causal_swa_block<bf16, bf16>(cur, cur, T, 1 << 30, (char*)lds, F.lds, S, F.tid);
            VM_WAIT(); __syncthreads();
        }
        VM_WAIT(); __syncthreads();
        for (int u = F.vcu; u < 8 * MS; u += F.G) if ((u & 7) == 0) ssel_unit(F.lds, SSC, SEL, u >> 3, F.tid, F.wave, F.lane);
        if (BOTH(3)) GRID_BAR();
    }
    if (IN(4)) { F.tid = wave0 * 64 + (int)__builtin_amdgcn_mbcnt_hi(~0u, __builtin_amdgcn_mbcnt_lo(~0u, 0u)); asm volatile("" : "+v"(F.tid)); asm volatile("" : "+s"(AP)); F.lane = F.tid & 63; F.wave = __builtin_amdgcn_readfirstlane(F.tid >> 6); asm volatile("; PHASE_MARK 4" ::: "memory");
        SAttArgs sa{QS, out + OUT_KS, out + OUT_VS, cache_k, cache_v, rel_bias, page_table, SEL, ATT};
        for (int L = F.vcu; L < MS * NH; L += F.G) satt_unit(F.lds, sa, L >> 3, L & 7, F.tid, F.wave, F.lane);
        if (BOTH(4)) GRID_BAR();
    }
    if (IN(5)) { F.tid = wave0 * 64 + (int)__builtin_amdgcn_mbcnt_hi(~0u, __builtin_amdgcn_mbcnt_lo(~0u, 0u)); asm volatile("" : "+v"(F.tid)); asm volatile("" : "+s"(AP)); F.lane = F.tid & 63; F.wave = __builtin_amdgcn_readfirstlane(F.tid >> 6); asm volatile("; PHASE_MARK 5" ::: "memory");
        pg8::Gemm g{ATT, WpaT, CBY, WpbT, AW}; pg8::StaticOrder S; S.init(MPAD, D, F.G, (int)blockIdx.x, 2);
        EpiMix E{SGA, SGB, MX};
        pg8::gemm_phase<EpiMix, pg8::StaticOrder, PG8_ALIGN, PG8_SP2>(F.lds + RING_OFF, g, S, E, F.tid);
        if (BOTH(5)) GRID_BAR();
    }
    if (IN(6)) { F.tid = wave0 * 64 + (int)__builtin_amdgcn_mbcnt_hi(~0u, __builtin_amdgcn_mbcnt_lo(~0u, 0u)); asm volatile("" : "+v"(F.tid)); asm volatile("" : "+s"(AP)); F.lane = F.tid & 63; F.wave = __builtin_amdgcn_readfirstlane(F.tid >> 6); asm volatile("; PHASE_MARK 6" ::: "memory");
        pg8::Gemm g{MX, WoT, MX, WoT, D}; pg8::StaticOrder S; S.init(MPAD, D, F.G, (int)blockIdx.x);
        EpiWo E{x_prompt, x_sample, X2, XB, SSQ1};
        pg8::gemm_phase<EpiWo, pg8::StaticOrder, PG8_ALIGN, PG8_SP2>(F.lds + RING_OFF, g, S, E, F.tid);
        if (BOTH(6)) GRID_BAR();
    }
    if (IN(7)) { F.tid = wave0 * 64 + (int)__builtin_amdgcn_mbcnt_hi(~0u, __builtin_amdgcn_mbcnt_lo(~0u, 0u)); asm volatile("" : "+v"(F.tid)); asm volatile("" : "+s"(AP)); F.lane = F.tid & 63; F.wave = __builtin_amdgcn_readfirstlane(F.tid >> 6); asm volatile("; PHASE_MARK 7" ::: "memory");
        pg8::Gemm g{XB, W1T, XB, W1T, D}; pg8::StaticOrder S; S.init(MPAD, FF, F.G, (int)blockIdx.x);
        EpiUp E{SSQ1, HID};
        pg8::gemm_phase<EpiUp, pg8::StaticOrder, PG8_ALIGN, PG8_SP2>(F.lds + RING_OFF, g, S, E, F.tid);
        if (BOTH(7)) GRID_BAR();
    }
    if (IN(8)) { F.tid = wave0 * 64 + (int)__builtin_amdgcn_mbcnt_hi(~0u, __builtin_amdgcn_mbcnt_lo(~0u, 0u)); asm volatile("" : "+v"(F.tid)); asm volatile("" : "+s"(AP)); F.lane = F.tid & 63; F.wave = __builtin_amdgcn_readfirstlane(F.tid >> 6); asm volatile("; PHASE_MARK 8" ::: "memory");
        pg8::Gemm g{HID, W2T, HID, W2T, FF}; pg8::StaticOrder S; S.init(MPAD, D, F.G, (int)blockIdx.x);
        EpiDown E{X2, out, SSQ2};
        pg8::gemm_phase<EpiDown, pg8::StaticOrder, PG8_ALIGN, PG8_SP2>(F.lds + RING_OFF, g, S, E, F.tid);
        if (BOTH(8)) GRID_BAR();
    }
    if (IN(9)) F.tid = wave0 * 64 + (int)__builtin_amdgcn_mbcnt_hi(~0u, __builtin_amdgcn_mbcnt_lo(~0u, 0u)); asm volatile("" : "+v"(F.tid)); asm volatile("" : "+s"(AP)); F.lane = F.tid & 63; F.wave = __builtin_amdgcn_readfirstlane(F.tid >> 6); asm volatile("; PHASE_MARK 9" ::: "memory");
    if (IN(9)) final_norm(F, out, SSQ2, norm_final_g);
#undef IN
#undef BOTH
#undef GRID_BAR
}
#undef x_prompt
#undef x_sample
#undef cache_k
#undef cache_v
#undef cache_kidx
#undef state_conv
#undef page_table
#undef rel_bias
#undef norm_mix_g
#undef w_in
#undef conv_w
#undef w_pa
#undef w_pb
#undef w_o
#undef norm_mlp_g
#undef w_mlp_in
#undef w_mlp_out
#undef norm_final_g
#undef out
#undef WinT
#undef WpaT
#undef WpbT
#undef WoT
#undef W1T
#undef W2T
#undef HBUF
#undef QH
#undef KH
#undef VH
#undef QI
#undef KIB
#undef WI
#undef CXB
#undef SGA
#undef SGB
#undef MASKW
#undef ATT
#undef CBY
#undef MX
#undef X2
#undef XB
#undef HID
#undef QS
#undef SSC
#undef SEL
#undef SSQ1
#undef SSQ2

template <int PH_LO, int PH_HI> static bool launch_range(int grid, const Args& a, hipStream_t stream) {
    static bool attr = false;
    if (!attr) { if (hipFuncSetAttribute((const void*)fwd<PH_LO, PH_HI>, hipFuncAttributeMaxDynamicSharedMemorySize, LDS_BYTES) != hipSuccess) { fprintf(stderr, "kernel_launch: hipFuncSetAttribute failed\n"); return false; } attr = true; }
    hipLaunchKernelGGL((fwd<PH_LO, PH_HI>), dim3(grid), dim3(NWAVES * 64), LDS_BYTES, stream, a);
    const hipError_t le = hipPeekAtLastError();
    if (le != hipSuccess) { fprintf(stderr, "kernel_launch: launch of phases [%d,%d) failed: %s\n", PH_LO, PH_HI, hipGetErrorName(le)); return false; }
    return true;
}
extern "C" void kernel_launch(void* const* d_in, const int* in_sizes, int n_in, void* d_out, int out_size, void* d_ws, size_t ws_size, hipStream_t stream) {
    static int grid = 0;
    if (grid == 0) {
        if (n_in != 18 || ws_size < WS_END) { fprintf(stderr, "kernel_launch: built for 18 inputs and >= %zu bytes of workspace; got n_in %d, ws %zu; nothing launched\n", (size_t)WS_END, n_in, ws_size); grid = -1; return; }
        int dev = 0, cus = 0;
        if (hipGetDevice(&dev) != hipSuccess || hipDeviceGetAttribute(&cus, hipDeviceAttributeMultiprocessorCount, dev) != hipSuccess) { grid = -1; return; }
        grid = cus;
    }
    if (grid < 0) return;
    (void)in_sizes; (void)out_size;
    if (hipMemsetAsync((char*)d_ws + WS_CTL, 0, CTL_ZERO_BYTES, stream) != hipSuccess) { fprintf(stderr, "kernel_launch: hipMemsetAsync failed\n"); return; }
    Args a{};
    for (int i = 0; i < 18; ++i) a.in[i] = d_in[i];
    a.out = (float*)d_out; a.ws = (unsigned char*)d_ws;
    if constexpr (N_LAUNCHES == 1) { launch_range<0, NPH>(grid, a, stream); }
    else {
        if (!launch_range<0, 1>(grid, a, stream)) return;
        if (!launch_range<1, 2>(grid, a, stream)) return;
        if (!launch_range<2, 3>(grid, a, stream)) return;
        if (!launch_range<3, 4>(grid, a, stream)) return;
        if (!launch_range<4, 5>(grid, a, stream)) return;
        if (!launch_range<5, 6>(grid, a, stream)) return;
        if (!launch_range<6, 7>(grid, a, stream)) return;
        if (!launch_range<7, 8>(grid, a, stream)) return;
        if (!launch_range<8, 9>(grid, a, stream)) return;
        launch_range<9, 10>(grid, a, stream);
    }
}
```
